# Optimizing an MI355X kernel written in HIP

```python
import math
import jax, jax.numpy as jnp
from jax import lax
import numpy as np

D_MODEL = 1024
BATCH = 8
SEQ = 2048
DEPTH = 2

FFN_DIM = 2816
RG_WIDTH = D_MODEL
RG_BLOCKS = 16
RG_BLOCK_DIM = RG_WIDTH // RG_BLOCKS
RG_C = 8.0
CONV_WIDTH = 4
ATT_GROUPS = ((128, 1), (512, 4), (2048, 16))
ATT_HEADS_PER_GROUP = 4
ATT_HEADS = ATT_HEADS_PER_GROUP * len(ATT_GROUPS)
ATT_HEAD_DIM = 64
ATT_WIDTH = ATT_HEADS * ATT_HEAD_DIM
DN_HEADS = 8
DN_HEAD_DIM = 128
DN_WIDTH = DN_HEADS * DN_HEAD_DIM
DN_CHUNK = 64
N_BRANCH = 3
EPS = 1e-6
NEG_INF = -1e30

IN_SPLITS = (RG_WIDTH, RG_WIDTH, ATT_WIDTH, ATT_WIDTH, ATT_WIDTH,
             DN_WIDTH, DN_WIDTH, DN_WIDTH, DN_WIDTH, DN_HEADS, DN_HEADS, N_BRANCH * D_MODEL)
IN_DIM = sum(IN_SPLITS)
IN_OFFSETS = tuple(int(v) for v in np.cumsum(IN_SPLITS)[:-1])
BRANCH_DIM = RG_WIDTH + ATT_WIDTH + DN_WIDTH
BRANCH_OFFSETS = (RG_WIDTH, RG_WIDTH + ATT_WIDTH)

kernel_name = 'hybrid_rglru_dilated_attn_gated_deltanet_macaron'


def rms_norm(x, g):
    xf = x.astype(jnp.float32)
    y = xf * lax.rsqrt(jnp.mean(xf * xf, axis=-1, keepdims=True) + EPS)
    return (y * g.astype(jnp.float32)).astype(x.dtype)


def l2_norm(x):
    xf = x.astype(jnp.float32)
    return xf * lax.rsqrt(jnp.sum(xf * xf, axis=-1, keepdims=True) + EPS)


def swiglu(x, w_gate, w_up, w_down):
    return (jax.nn.silu(x @ w_gate) * (x @ w_up)) @ w_down


def causal_depthwise_conv(x, w):
    K = w.shape[0]
    T = x.shape[1]
    xp = jnp.pad(x, ((0, 0), (K - 1, 0), (0, 0)))
    out = xp[:, 0:T] * w[0]
    for k in range(1, K):
        out = out + xp[:, k:k + T] * w[k]
    return out


def rg_lru(x, w_r, b_r, w_i, b_i, lam):
    B, T, C = x.shape
    xb = x.reshape(B, T, RG_BLOCKS, RG_BLOCK_DIM)
    r = jax.nn.sigmoid((jnp.einsum('btnc,ncd->btnd', xb, w_r).reshape(B, T, C) + b_r).astype(jnp.float32))
    i = jax.nn.sigmoid((jnp.einsum('btnc,ncd->btnd', xb, w_i).reshape(B, T, C) + b_i).astype(jnp.float32))
    log_a = -RG_C * r * jax.nn.softplus(-lam.astype(jnp.float32))
    a = jnp.exp(log_a)
    b = jnp.sqrt(-jnp.expm1(2.0 * log_a)) * (i * x.astype(jnp.float32))

    def combine(c1, c2):
        a1, b1 = c1
        a2, b2 = c2
        return a1 * a2, a2 * b1 + b2

    _, h = lax.associative_scan(combine, (a, b), axis=1)
    return h.astype(x.dtype)


def alibi_slopes():
    h = jnp.arange(1, ATT_HEADS + 1, dtype=jnp.float32)
    return jnp.exp2(-8.0 * h / ATT_HEADS)


def dilated_window_attention(q, k, v, slopes, window, dilation):
    B, T, H, hd = q.shape
    span = window // dilation
    L = T // dilation
    nblk = -(-L // span)
    Lp = nblk * span

    def to_blocks(t):
        t = t.reshape(B, L, dilation, H, hd).transpose(0, 2, 1, 3, 4)
        t = jnp.pad(t, ((0, 0), (0, 0), (0, Lp - L), (0, 0), (0, 0)))
        return t.reshape(B, dilation, nblk, span, H, hd)

    def with_prev(t):
        prev = jnp.pad(t, ((0, 0), (0, 0), (1, 0), (0, 0), (0, 0), (0, 0)))[:, :, :-1]
        return jnp.concatenate([prev, t], axis=3)

    qb = to_blocks(q)
    kw = with_prev(to_blocks(k))
    vw = with_prev(to_blocks(v))
    s = jnp.einsum('brnqhe,brnkhe->brnhqk', qb, kw).astype(jnp.float32)
    qi = jnp.arange(span)[:, None]
    kj = jnp.arange(2 * span)[None, :]
    delta = qi + span - kj
    blk = jnp.arange(nblk)[:, None, None]
    valid = (delta >= 0) & (delta <= span) & ((blk > 0) | (kj >= span))
    bias = -slopes[:, None, None] * (delta * dilation).astype(jnp.float32)
    s = jnp.where(valid[:, None], s + bias, NEG_INF)
    m = jnp.max(s, axis=-1, keepdims=True)
    p = jnp.exp(s - m)
    den = jnp.sum(p, axis=-1, keepdims=True)
    o = jnp.einsum('brnhqk,brnkhe->brnqhe', (p / den).astype(v.dtype), vw)
    lse = (m + jnp.log(den))[..., 0]
    o = o.reshape(B, dilation, Lp, H, hd)[:, :, :L].transpose(0, 2, 1, 3, 4).reshape(B, T, H, hd)
    lse = lse.transpose(0, 1, 2, 4, 3).reshape(B, dilation, Lp, H)[:, :, :L]
    lse = lse.transpose(0, 2, 1, 3).reshape(B, T, H)
    return o, lse


def chunk_gated_delta_rule(q, k, v, g_log, beta):
    B, T, H, dk = q.shape
    dv = v.shape[-1]
    C = DN_CHUNK
    N = T // C
    f32 = jnp.float32

    def chunks(t):
        t = t.astype(f32).reshape((B, N, C, H) + t.shape[3:])
        return jnp.moveaxis(t, 3, 1)

    qc, kc, vc = chunks(q), chunks(k), chunks(v)
    gc, bc = chunks(g_log), chunks(beta)
    gam = jnp.cumsum(gc, axis=-1)
    incl = jnp.tril(jnp.ones((C, C), bool))
    strict = jnp.tril(jnp.ones((C, C), bool), -1)
    diff = gam[..., :, None] - gam[..., None, :]
    decay = jnp.where(incl, jnp.exp(jnp.where(incl, diff, 0.0)), 0.0)
    kb = kc * bc[..., None]
    vb = vc * bc[..., None]
    a = jnp.where(strict, jnp.einsum('bhnid,bhnjd->bhnij', kb, kc) * decay, 0.0)
    rhs = jnp.concatenate([vb, kb * jnp.exp(gam)[..., None]], axis=-1)
    sol = lax.linalg.triangular_solve(a + jnp.eye(C, dtype=f32), rhs, left_side=True, lower=True,
                                      unit_diagonal=True)
    u0, wk = sol[..., :dv], sol[..., dv:]
    qk = jnp.where(incl, jnp.einsum('bhnid,bhnjd->bhnij', qc, kc) * decay, 0.0)
    q_dec = qc * jnp.exp(gam)[..., None]
    k_dec = kc * jnp.exp(gam[..., -1:] - gam)[..., None]
    c_dec = jnp.exp(gam[..., -1])
    xs = tuple(jnp.moveaxis(t, 2, 0) for t in (u0, wk, qk, q_dec, k_dec, c_dec))

    def step(S, inp):
        u0_n, w_n, qk_n, qd_n, kd_n, cd_n = inp
        u = u0_n - jnp.einsum('bhck,bhkv->bhcv', w_n, S)
        o = jnp.einsum('bhck,bhkv->bhcv', qd_n, S) + jnp.einsum('bhij,bhjv->bhiv', qk_n, u)
        S = S * cd_n[..., None, None] + jnp.einsum('bhck,bhcv->bhkv', kd_n, u)
        return S, o

    S0 = jnp.zeros((B, H, dk, dv), f32)
    _, o = lax.scan(step, S0, xs)
    return jnp.transpose(o, (1, 0, 3, 2, 4)).reshape(B, T, H, dv)


def hybrid_mixer(u, w_in, rg_conv_w, rg_conv_b, rg_w_r, rg_b_r, rg_w_i, rg_b_i, rg_lambda,
                 att_q_norm, att_k_norm, dn_conv_w, dn_a_log, dn_dt_bias, dn_out_norm, w_branch, w_out):
    B, T, _ = u.shape
    proj = u @ w_in
    (rg_x, rg_gate, aq, ak, av, dq, dk_, dv_, dz, d_beta, d_alpha, merge_logits) = jnp.split(
        proj, IN_OFFSETS, axis=-1)

    xa = causal_depthwise_conv(rg_x, rg_conv_w) + rg_conv_b
    ya = rg_lru(xa, rg_w_r, rg_b_r, rg_w_i, rg_b_i, rg_lambda) * jax.nn.gelu(rg_gate)

    hshape = (B, T, ATT_HEADS, ATT_HEAD_DIM)
    q = rms_norm(aq.reshape(hshape), att_q_norm) * (ATT_HEAD_DIM ** -0.5)
    k = rms_norm(ak.reshape(hshape), att_k_norm)
    v = av.reshape(hshape)
    slopes = alibi_slopes()
    outs, lses = [], []
    for g, (window, dilation) in enumerate(ATT_GROUPS):
        hs = slice(g * ATT_HEADS_PER_GROUP, (g + 1) * ATT_HEADS_PER_GROUP)
        o_g, lse_g = dilated_window_attention(q[:, :, hs], k[:, :, hs], v[:, :, hs], slopes[hs], window, dilation)
        outs.append(o_g)
        lses.append(lse_g)
    wts = jax.nn.softmax(jnp.stack(lses, axis=0), axis=0)
    o_att = jnp.stack(outs, axis=0) * wts[..., None].astype(v.dtype)
    yb = o_att.transpose(1, 2, 0, 3, 4).reshape(B, T, ATT_WIDTH)

    qkv = jax.nn.silu(causal_depthwise_conv(jnp.concatenate([dq, dk_, dv_], axis=-1), dn_conv_w))
    cq, ck, cv = jnp.split(qkv, 3, axis=-1)
    dshape = (B, T, DN_HEADS, DN_HEAD_DIM)
    qd = l2_norm(cq.reshape(dshape)) * (DN_HEAD_DIM ** -0.5)
    kd = l2_norm(ck.reshape(dshape))
    vd = cv.reshape(dshape)
    beta = jax.nn.sigmoid(d_beta.astype(jnp.float32))
    g_log = -jnp.exp(dn_a_log.astype(jnp.float32)) * jax.nn.softplus(
        d_alpha.astype(jnp.float32) + dn_dt_bias.astype(jnp.float32))
    o_dn = chunk_gated_delta_rule(qd, kd, vd, g_log, beta)
    yc = (rms_norm(o_dn, dn_out_norm) * jax.nn.silu(dz.reshape(dshape).astype(jnp.float32)))
    yc = yc.reshape(B, T, DN_WIDTH).astype(u.dtype)

    gates = jax.nn.sigmoid(merge_logits.reshape(B, T, N_BRANCH, D_MODEL))
    wa, wb, wc = jnp.split(w_branch, BRANCH_OFFSETS, axis=0)
    y = gates[:, :, 0] * (ya @ wa) + gates[:, :, 1] * (yb @ wb) + gates[:, :, 2] * (yc @ wc)
    return y @ w_out


def setup_inputs(seed: int = 0) -> dict:
    key = jax.random.key(seed)
    ks = jax.random.split(key, 32)
    f32 = jnp.float32
    L, D, F = DEPTH, D_MODEL, FFN_DIM

    def dense(k, shape, fan_in):
        return jax.random.normal(k, shape, f32) * (fan_in ** -0.5)

    def gain(k, shape):
        return 1.0 + 0.05 * jax.random.normal(k, shape, f32)

    def bias(k, shape):
        return 0.02 * jax.random.normal(k, shape, f32)

    x = jax.random.normal(ks[0], (BATCH, SEQ, D), f32)
    a0 = jax.random.uniform(ks[13], (L, RG_WIDTH), f32, 0.9, 0.999)
    s = a0 ** (1.0 / RG_C)
    rg_lambda = jnp.log(s) - jnp.log1p(-s)
    dn_a_log = jnp.log(jax.random.uniform(ks[17], (L, DN_HEADS), f32, 1.0, 16.0))
    dt = jnp.exp(jax.random.uniform(ks[18], (L, DN_HEADS), f32, math.log(1e-3), math.log(1e-1)))
    dn_dt_bias = dt + jnp.log(-jnp.expm1(-dt))
    w_branch = jnp.concatenate([
        dense(ks[20], (L, RG_WIDTH, D), RG_WIDTH),
        dense(ks[21], (L, ATT_WIDTH, D), ATT_WIDTH),
        dense(ks[22], (L, DN_WIDTH, D), DN_WIDTH)], axis=1)
    return {
        'x': x,
        'ffn1_norm': gain(ks[1], (L, D)),
        'ffn1_w_gate': dense(ks[2], (L, D, F), D),
        'ffn1_w_up': dense(ks[3], (L, D, F), D),
        'ffn1_w_down': dense(ks[4], (L, F, D), F),
        'mix_norm': gain(ks[5], (L, D)),
        'w_in': dense(ks[6], (L, D, IN_DIM), D),
        'rg_conv_w': dense(ks[7], (L, CONV_WIDTH, RG_WIDTH), CONV_WIDTH),
        'rg_conv_b': bias(ks[8], (L, RG_WIDTH)),
        'rg_w_r': dense(ks[9], (L, RG_BLOCKS, RG_BLOCK_DIM, RG_BLOCK_DIM), RG_BLOCK_DIM),
        'rg_b_r': bias(ks[10], (L, RG_WIDTH)),
        'rg_w_i': dense(ks[11], (L, RG_BLOCKS, RG_BLOCK_DIM, RG_BLOCK_DIM), RG_BLOCK_DIM),
        'rg_b_i': bias(ks[12], (L, RG_WIDTH)),
        'rg_lambda': rg_lambda,
        'att_q_norm': gain(ks[14], (L, ATT_HEADS, ATT_HEAD_DIM)),
        'att_k_norm': gain(ks[15], (L, ATT_HEADS, ATT_HEAD_DIM)),
        'dn_conv_w': dense(ks[16], (L, CONV_WIDTH, 3 * DN_WIDTH), CONV_WIDTH),
        'dn_a_log': dn_a_log,
        'dn_dt_bias': dn_dt_bias,
        'dn_out_norm': gain(ks[19], (L, DN_HEADS, DN_HEAD_DIM)),
        'w_branch': w_branch,
        'w_out': dense(ks[23], (L, D, D), D),
        'ffn2_norm': gain(ks[24], (L, D)),
        'ffn2_w_gate': dense(ks[25], (L, D, F), D),
        'ffn2_w_up': dense(ks[26], (L, D, F), D),
        'ffn2_w_down': dense(ks[27], (L, F, D), F),
    }


def reference(x, ffn1_norm, ffn1_w_gate, ffn1_w_up, ffn1_w_down, mix_norm, w_in,
              rg_conv_w, rg_conv_b, rg_w_r, rg_b_r, rg_w_i, rg_b_i, rg_lambda,
              att_q_norm, att_k_norm, dn_conv_w, dn_a_log, dn_dt_bias, dn_out_norm,
              w_branch, w_out, ffn2_norm, ffn2_w_gate, ffn2_w_up, ffn2_w_down):
    for l in range(DEPTH):
        x = x + 0.5 * swiglu(rms_norm(x, ffn1_norm[l]), ffn1_w_gate[l], ffn1_w_up[l], ffn1_w_down[l])
        x = x + hybrid_mixer(rms_norm(x, mix_norm[l]), w_in[l], rg_conv_w[l], rg_conv_b[l],
                             rg_w_r[l], rg_b_r[l], rg_w_i[l], rg_b_i[l], rg_lambda[l],
                             att_q_norm[l], att_k_norm[l], dn_conv_w[l], dn_a_log[l], dn_dt_bias[l],
                             dn_out_norm[l], w_branch[l], w_out[l])
        x = x + 0.5 * swiglu(rms_norm(x, ffn2_norm[l]), ffn2_w_gate[l], ffn2_w_up[l], ffn2_w_down[l])
    return x
```

```cpp
#include <hip/hip_runtime.h>
#include <hip/hip_cooperative_groups.h>
#include <cstdio>
#include <cstdint>
namespace cg = cooperative_groups;
namespace pg8 {
#define PG8_LAS __attribute__((address_space(3)))
typedef unsigned short bf16_t;
typedef short bf16x8 __attribute__((ext_vector_type(8)));
typedef float f32x4 __attribute__((ext_vector_type(4)));
typedef unsigned u32x4 __attribute__((ext_vector_type(4)));
constexpr int BM = 256, BK = 64, HALF = 128, HTB = HALF * BK * 2  , STAGE_BYTES = 8 * HTB, NXCD = 8, WGM = 4;

__host__ __device__ __forceinline__ int lds_byte(int r, int c) { const int st = (r >> 4) * 2 + (c >> 5), rr = r & 15, cc = c & 31, ob = rr * 64 + cc * 2; return st * 1024 + (ob ^ (((ob >> 9) & 1) << 5)); }
__host__ __device__ __forceinline__ void stage_rc(int b, int& R, int& C) { const int st = b / 1024, sb = b % 1024, swz = sb ^ (((sb >> 9) & 1) << 5); R = (st >> 1) * 16 + swz / 64; C = (st & 1) * 32 + (swz % 64) / 2; }
__host__ __device__ __forceinline__ int perm32(int rho) { const int n = rho >> 4, i = rho & 15; return 8 * (i >> 2) + 4 * n + (i & 3); }

struct Unit { int pm, pn; };
struct Gemm { const bf16_t* A; const bf16_t* Bt; int M, N, K; };

struct StaticOrder {
    int nM, nN, nwg, G, c;
    __host__ __device__ void init(int M, int N, int G_, int c_) { nM = M / BM; nN = N / BM; nwg = nM * nN; G = G_; c = c_; }
    __host__ __device__ bool next(int i, Unit& u) const {
        const long L = (long)i * G + c; if (L >= nwg) return false;
        int wgid = (int)L; { const int q = nwg / NXCD, r = nwg % NXCD, xcd = wgid % NXCD, off = wgid / NXCD; wgid = (xcd < r ? xcd * (q + 1) : r * (q + 1) + (xcd - r) * q) + off; }
        const int nig = WGM * nN, gid = wgid / nig, fm = gid * WGM, gsz = (nM - fm) < WGM ? (nM - fm) : WGM;
        u.pm = fm + ((wgid % nig) % gsz); u.pn = (wgid % nig) / gsz; return true;
    }
    __device__ __forceinline__ void a_ready(const Unit&) const {}
    __device__ __forceinline__ void done(const Unit&) const {}
};

template <class Epi, class Sched, bool ALIGN_EPI = false, bool SP2 = false>
__device__ __forceinline__ void gemm_phase(PG8_LAS unsigned char* lds, const Gemm g, const Sched& S, const Epi& E) {
    int tid_ = threadIdx.x; asm volatile("" : "+v"(tid_));
    const int tid = tid_, wid = __builtin_amdgcn_readfirstlane(tid >> 6), lane = tid & 63, wr = wid >> 2, wc = wid & 3, fr = lane & 15, fq = lane >> 4;
    const int K = g.K, nt = K / BK;
    unsigned voffA[2], voffB[2];
#pragma unroll
    for (int i = 0; i < 2; ++i) { int R, C; stage_rc(tid * 16 + i * 8192, R, C); const int Rb = Epi::PERM ? ((R & ~31) + perm32(R & 31)) : R;
        voffA[i] = (unsigned)(R * K + C) * 2u; voffB[i] = (unsigned)(Rb * K + C) * 2u; }
    const size_t kstep = (size_t)(BK * 2);
    const size_t hstep = (size_t)HALF * K * 2;
    const size_t tstep = 2 * hstep;
    const unsigned ldsw = (unsigned)wid * 1024u;
    const int aoff = lds_byte(wr * 64 + fr, fq * 8), boff = lds_byte(wc * 32 + fr, fq * 8);
#define PG8_SA(b, h) (((b) * 2 + (h)) * HTB)
#define PG8_SB(b, h) ((4 + (b) * 2 + (h)) * HTB)
#define PG8_STAGE(bufoff, gbase, voff) do { _Pragma("unroll") for (int _i = 0; _i < 2; ++_i) \
        __builtin_amdgcn_global_load_lds((const unsigned*)((const char*)(gbase) + (voff)[_i]), (PG8_LAS unsigned*)(lds + (bufoff) + ldsw + _i * 8192), 16, 0, 0); } while (0)
#define PG8_LDA(dst, b, h) do { _Pragma("unroll") for (int m = 0; m < 4; ++m) _Pragma("unroll") for (int k = 0; k < 2; ++k) dst[m][k] = *(const PG8_LAS bf16x8*)(lds + PG8_SA(b, h) + aoff + m * 2048 + k * 1024); } while (0)
#define PG8_LDB(dst, b, h) do { _Pragma("unroll") for (int n = 0; n < 2; ++n) _Pragma("unroll") for (int k = 0; k < 2; ++k) dst[n][k] = *(const PG8_LAS bf16x8*)(lds + PG8_SB(b, h) + boff + n * 2048 + k * 1024); } while (0)
#define PG8_MMA(ai, bj, At, Bt) do { __builtin_amdgcn_s_setprio(1); _Pragma("unroll") for (int m = 0; m < 4; ++m) _Pragma("unroll") for (int n = 0; n < 2; ++n) _Pragma("unroll") for (int k = 0; k < 2; ++k) \
        acc[ai][bj][m][n] = __builtin_amdgcn_mfma_f32_16x16x32_bf16(Bt[n][k], At[m][k], acc[ai][bj][m][n], 0, 0, 0); __builtin_amdgcn_s_setprio(0); } while (0)
#define PG8_WAIT_V(n) asm volatile("s_waitcnt vmcnt(" #n ")" ::: "memory")
#define PG8_WAIT_L(n) asm volatile("s_waitcnt lgkmcnt(" #n ")" ::: "memory")
#define PG8_BAR __builtin_amdgcn_s_barrier()
#define PG8_SCHED __builtin_amdgcn_sched_barrier(0)
    Unit cur, nxt; int ui = 0;
    if (!S.next(0, cur)) return;
    f32x4 acc[2][2][4][2];
#pragma unroll
    for (int a = 0; a < 2; ++a)
#pragma unroll
        for (int b = 0; b < 2; ++b)
#pragma unroll
            for (int m = 0; m < 4; ++m)
#pragma unroll
                for (int n = 0; n < 2; ++n) acc[a][b][m][n] = (f32x4){0.f, 0.f, 0.f, 0.f};
    bf16x8 At[4][2], B0[2][2], B1[2][2];
    const char* cA = (const char*)g.A + (size_t)cur.pm * tstep; const char* cB = (const char*)g.Bt + (size_t)cur.pn * tstep;
    S.a_ready(cur);
    if constexpr (SP2) {
        PG8_STAGE(PG8_SB(0, 0), cB, voffB); PG8_STAGE(PG8_SB(0, 1), cB + hstep, voffB); PG8_STAGE(PG8_SA(0, 0), cA, voffA); PG8_STAGE(PG8_SA(0, 1), cA + hstep, voffA);
        if (wr == 1) PG8_BAR;
        PG8_WAIT_V(2); PG8_BAR;
        PG8_STAGE(PG8_SB(1, 0), cB + kstep, voffB); PG8_STAGE(PG8_SA(1, 0), cA + kstep, voffA); PG8_STAGE(PG8_SB(1, 1), cB + hstep + kstep, voffB);
        PG8_WAIT_V(6); PG8_BAR;
    } else {
        PG8_STAGE(PG8_SB(0, 0), cB, voffB); PG8_STAGE(PG8_SA(0, 0), cA, voffA); PG8_STAGE(PG8_SB(0, 1), cB + hstep, voffB); PG8_STAGE(PG8_SA(0, 1), cA + hstep, voffA);
        if (wr == 1) PG8_BAR;
        PG8_WAIT_V(4); PG8_BAR;
        PG8_STAGE(PG8_SB(1, 0), cB + kstep, voffB); PG8_STAGE(PG8_SA(1, 0), cA + kstep, voffA); PG8_STAGE(PG8_SB(1, 1), cB + hstep + kstep, voffB);
        PG8_WAIT_V(6); PG8_BAR;
    }
    for (;;) {
        const bool has_next = S.next(ui + 1, nxt);
        const char* nA = has_next ? (const char*)g.A + (size_t)nxt.pm * tstep : cA; const char* nB = has_next ? (const char*)g.Bt + (size_t)nxt.pn * tstep : cB;
        for (int t = 0; t < nt; t += 2) {
            const bool last = (t == nt - 2);
            const char* a1 = cA + (size_t)(t + 1) * kstep;
            const char* a2 = last ? nA : cA + (size_t)(t + 2) * kstep; const char* b2 = last ? nB : cB + (size_t)(t + 2) * kstep;
            const char* a3 = a2 + kstep; const char* b3 = b2 + kstep;
            if (last && has_next) S.a_ready(nxt);
            if constexpr (SP2) {
            PG8_LDB(B0, 0, 0); PG8_LDB(B1, 0, 1); PG8_SCHED; PG8_LDA(At, 0, 0); PG8_STAGE(PG8_SA(1, 1), a1 + hstep, voffA);
            PG8_WAIT_V(8); PG8_WAIT_L(0); PG8_BAR; PG8_MMA(0, 0, At, B0); PG8_MMA(0, 1, At, B1); PG8_BAR; PG8_SCHED;
            PG8_LDA(At, 0, 1); PG8_STAGE(PG8_SB(0, 0), b2, voffB); PG8_STAGE(PG8_SB(0, 1), b2 + hstep, voffB); PG8_STAGE(PG8_SA(0, 0), a2, voffA);
            PG8_WAIT_V(8); PG8_WAIT_L(0); PG8_BAR; PG8_MMA(1, 0, At, B0); PG8_MMA(1, 1, At, B1); PG8_BAR; PG8_SCHED;
            PG8_LDB(B0, 1, 0); PG8_LDB(B1, 1, 1); PG8_SCHED; PG8_LDA(At, 1, 0); PG8_STAGE(PG8_SA(0, 1), a2 + hstep, voffA);
            PG8_WAIT_V(8); PG8_WAIT_L(0); PG8_BAR; PG8_MMA(0, 0, At, B0); PG8_MMA(0, 1, At, B1); PG8_BAR; PG8_SCHED;
            PG8_LDA(At, 1, 1); PG8_STAGE(PG8_SB(1, 0), b3, voffB); PG8_STAGE(PG8_SB(1, 1), b3 + hstep, voffB); PG8_STAGE(PG8_SA(1, 0), a3, voffA);
            PG8_WAIT_V(8); PG8_WAIT_L(0); PG8_BAR; PG8_MMA(1, 0, At, B0); PG8_MMA(1, 1, At, B1); PG8_BAR; PG8_SCHED;
            } else {
            PG8_LDB(B0, 0, 0); PG8_SCHED; PG8_LDA(At, 0, 0); PG8_STAGE(PG8_SA(1, 1), a1 + hstep, voffA);
            PG8_WAIT_L(8); PG8_BAR; PG8_WAIT_L(0); PG8_MMA(0, 0, At, B0); PG8_BAR; PG8_SCHED;
            PG8_LDB(B1, 0, 1); PG8_STAGE(PG8_SB(0, 0), b2, voffB);
            PG8_BAR; PG8_WAIT_L(0); PG8_MMA(0, 1, At, B1); PG8_BAR;
            PG8_LDA(At, 0, 1); PG8_STAGE(PG8_SA(0, 0), a2, voffA);
            PG8_BAR; PG8_WAIT_L(0); PG8_MMA(1, 0, At, B0); PG8_BAR; PG8_SCHED;
            PG8_STAGE(PG8_SB(0, 1), b2 + hstep, voffB);
            PG8_WAIT_V(6); PG8_BAR; PG8_MMA(1, 1, At, B1); PG8_BAR;
            PG8_LDB(B0, 1, 0); PG8_SCHED; PG8_LDA(At, 1, 0); PG8_STAGE(PG8_SA(0, 1), a2 + hstep, voffA);
            PG8_WAIT_L(8); PG8_BAR; PG8_WAIT_L(0); PG8_MMA(0, 0, At, B0); PG8_BAR; PG8_SCHED;
            PG8_LDB(B1, 1, 1); PG8_STAGE(PG8_SB(1, 0), b3, voffB);
            PG8_BAR; PG8_WAIT_L(0); PG8_MMA(0, 1, At, B1); PG8_BAR;
            PG8_LDA(At, 1, 1); PG8_STAGE(PG8_SA(1, 0), a3, voffA);
            PG8_BAR; PG8_WAIT_L(0); PG8_MMA(1, 0, At, B0); PG8_BAR; PG8_SCHED;
            PG8_STAGE(PG8_SB(1, 1), b3 + hstep, voffB);
            PG8_WAIT_V(6); PG8_BAR; PG8_MMA(1, 1, At, B1); PG8_BAR;
            }
        }
        if constexpr (ALIGN_EPI) { if (wr == 0) PG8_BAR; }
        if constexpr (!Epi::AFTER_DRAIN) { E(acc, cur, wr, wc, fr, fq); S.done(cur); }
        if (!has_next) break;
#pragma unroll
        for (int a = 0; a < 2; ++a)
#pragma unroll
            for (int b = 0; b < 2; ++b)
#pragma unroll
                for (int m = 0; m < 4; ++m)
#pragma unroll
                    for (int n = 0; n < 2; ++n) acc[a][b][m][n] = (f32x4){0.f, 0.f, 0.f, 0.f};
        cur = nxt; cA = nA; cB = nB; ++ui;
        if constexpr (ALIGN_EPI) { if (wr == 1) PG8_BAR; }
    }
    PG8_WAIT_V(0);
    if constexpr (!ALIGN_EPI) { if (wr == 0) PG8_BAR; }
    PG8_BAR;
    if constexpr (Epi::AFTER_DRAIN) { E.fused(acc, cur, wr, wc, fr, fq, lds, wid, lane); S.done(cur); }
#undef PG8_SA
#undef PG8_SB
#undef PG8_STAGE
#undef PG8_LDA
#undef PG8_LDB
#undef PG8_MMA
#undef PG8_WAIT_V
#undef PG8_WAIT_L
#undef PG8_BAR
#undef PG8_SCHED
}
}

#define GAS __attribute__((address_space(1)))
#define LAS __attribute__((address_space(3)))
typedef unsigned short bf16;
typedef unsigned v4u __attribute__((ext_vector_type(4)));
typedef unsigned v2u __attribute__((ext_vector_type(2)));
typedef float f32x4 __attribute__((ext_vector_type(4)));
typedef float f32x2 __attribute__((ext_vector_type(2)));
typedef short bf16x8 __attribute__((ext_vector_type(8)));

constexpr int NWAVES = 8, NTHREADS = 512;
constexpr int BATCH = 8, SEQ = 2048, D = 1024, FF = 2816, M = BATCH * SEQ, DEPTH = 2;
constexpr int NSPLIT = 2, MS = M / NSPLIT, BS = BATCH / NSPLIT;
constexpr int IN_DIM = 11536, NPROJ = 11520;
constexpr int ATT_W = 768, NHEAD = 12, HD = 64;
constexpr int DNH = 8, DNK = 128;
constexpr float EPS = 1e-6f;

constexpr size_t MiB = 1u << 20;
constexpr size_t WS_CTL = 0;
constexpr size_t WS_WT = 1 * MiB;
constexpr size_t WS_W1T = WS_WT, WS_W2T = WS_WT + 11 * MiB;
constexpr size_t WS_WINT = WS_WT, WS_WBA = 24 * MiB, WS_WBB = 26 * MiB, WS_WBC = 28 * MiB, WS_WOUT = 30 * MiB;
constexpr size_t WS_XN = 32 * MiB;
constexpr size_t WS_BA = 64 * MiB;
constexpr size_t WS_LSE = 65 * MiB;
constexpr size_t WS_H = 66 * MiB;
constexpr size_t WS_RGX = 66 * MiB, WS_RGG = 82 * MiB, WS_AQ = 98 * MiB, WS_AK = 110 * MiB, WS_AV = 122 * MiB;
constexpr size_t WS_DQ = 134 * MiB, WS_DK = 150 * MiB, WS_DV = 166 * MiB, WS_DZ = 182 * MiB, WS_GATE = 198 * MiB;
constexpr size_t WS_U0T = 246 * MiB, WS_WK = 278 * MiB, WS_QD = 294 * MiB, WS_KDT = 310 * MiB, WS_QK = 326 * MiB;
constexpr size_t WS_YA = 334 * MiB, WS_SST = 350 * MiB, WS_END = 352 * MiB;
constexpr size_t WS_YB = WS_AQ, WS_YM = WS_DQ, WS_Y = WS_DV;
#define WS_YC_OF(s_) (WS_XN + (size_t)(s_) * MS * D * 2)
constexpr int LDS_BYTES = 147456;

typedef __bf16 hwbf16x2 __attribute__((ext_vector_type(2)));
__device__ __forceinline__ unsigned pk2(float lo, float hi) { const f32x2 v = {lo, hi}; return __builtin_bit_cast(unsigned, __builtin_convertvector(v, hwbf16x2)); }
__device__ __forceinline__ unsigned f2bf(float f) { return pk2(f, 0.f) & 0xffffu; }
__device__ __forceinline__ float bf2f(unsigned h) { return __builtin_bit_cast(float, h << 16); }
__device__ __forceinline__ float bflo(unsigned w) { return __builtin_bit_cast(float, w << 16); }
__device__ __forceinline__ float bfhi(unsigned w) { return __builtin_bit_cast(float, w & 0xffff0000u); }
__device__ __forceinline__ float fsigmoid(float v) { return __builtin_amdgcn_rcpf(1.f + __expf(-v)); }
__device__ __forceinline__ float fsilu(float v) { return v * fsigmoid(v); }
__device__ __forceinline__ float fgelu_tanh(float v) { const float u = 0.7978845608028654f * (v + 0.044715f * v * v * v); return v * fsigmoid(2.f * u); }
__device__ __forceinline__ float fsoftplus(float v) { return v > 20.f ? v : log1pf(__expf(v)); }
__device__ __forceinline__ float wave_sum(float v) {
#pragma unroll
    for (int o = 1; o < 64; o <<= 1) v += __shfl_xor(v, o);
    return v;
}
#define LDS_WAIT() asm volatile("s_waitcnt lgkmcnt(0)" ::: "memory")
template <int CTRL> __device__ __forceinline__ float dpp_mov(float v) { return __builtin_bit_cast(float, __builtin_amdgcn_update_dpp(0, __builtin_bit_cast(int, v), CTRL, 0xf, 0xf, false)); }
__device__ __forceinline__ float row16_sum(float v) { v += dpp_mov<0x128>(v); v += dpp_mov<0x124>(v); v += dpp_mov<0x122>(v); v += dpp_mov<0x121>(v); return v; }
__device__ __forceinline__ float row16_max(float v) { v = fmaxf(v, dpp_mov<0x128>(v)); v = fmaxf(v, dpp_mov<0x124>(v)); v = fmaxf(v, dpp_mov<0x122>(v)); v = fmaxf(v, dpp_mov<0x121>(v)); return v; }

using pg8::Unit;
typedef pg8::f32x4 (AccT)[2][2][4][2];
struct EpiFfnUp {
    static constexpr bool PERM = true, AFTER_DRAIN = false; bf16* H;
    __device__ __forceinline__ void operator()(const pg8::f32x4 (&acc)[2][2][4][2], const Unit& u, int wr, int wc, int fr, int fq) const {
        const int row0 = u.pm * 256 + wr * 64 + fr, col0 = u.pn * 128 + wc * 32 + 8 * fq;
#pragma unroll
        for (int ai = 0; ai < 2; ++ai)
#pragma unroll
            for (int m = 0; m < 4; ++m) {
                bf16* p = H + (size_t)(row0 + ai * 128 + m * 16) * FF + col0;
                float h[8];
#pragma unroll
                for (int n = 0; n < 2; ++n)
#pragma unroll
                    for (int e = 0; e < 4; ++e) h[n * 4 + e] = fsilu(acc[ai][0][m][n][e]) * acc[ai][1][m][n][e];
                v4u w; w.x = pk2(h[0], h[1]); w.y = pk2(h[2], h[3]); w.z = pk2(h[4], h[5]); w.w = pk2(h[6], h[7]);
                *(v4u*)p = w;
            }
    }
};
struct EpiResid {
    static constexpr bool PERM = false, AFTER_DRAIN = false; float* X; float scale; const float* Xsrc;
    __device__ __forceinline__ void operator()(const pg8::f32x4 (&acc)[2][2][4][2], const Unit& u, int wr, int wc, int fr, int fq) const {
        const int row0 = u.pm * 256 + wr * 64 + fr, col0 = u.pn * 256 + wc * 32 + 4 * fq; const ptrdiff_t sd = Xsrc - X;
#pragma unroll
        for (int ai = 0; ai < 2; ++ai)
#pragma unroll
            for (int m = 0; m < 4; ++m) {
                float* p = X + (size_t)(row0 + ai * 128 + m * 16) * D + col0;
#pragma unroll
                for (int bj = 0; bj < 2; ++bj)
#pragma unroll
                    for (int n = 0; n < 2; ++n) { f32x4* q = (f32x4*)(p + bj * 128 + n * 16); f32x4 v = *(const f32x4*)((const float*)q + sd); v = v + acc[ai][bj][m][n] * scale; *q = v; }
                asm volatile("" ::: "memory");
            }
    }
};
struct EpiInProj {
    static constexpr bool PERM = true, AFTER_DRAIN = false; unsigned char* ws;
    __device__ __forceinline__ void operator()(const pg8::f32x4 (&acc)[2][2][4][2], const Unit& u, int wr, int wc, int fr, int fq) const {
        const int pn = u.pn; size_t off; int t0, width, act = 0;
        if (pn < 4) { off = WS_RGX; t0 = 0; width = 1024; }
        else if (pn < 8) { off = WS_RGG; t0 = 4; width = 1024; act = 1; }
        else if (pn < 11) { off = WS_AQ; t0 = 8; width = 768; }
        else if (pn < 14) { off = WS_AK; t0 = 11; width = 768; }
        else if (pn < 17) { off = WS_AV; t0 = 14; width = 768; }
        else if (pn < 21) { off = WS_DQ; t0 = 17; width = 1024; }
        else if (pn < 25) { off = WS_DK; t0 = 21; width = 1024; }
        else if (pn < 29) { off = WS_DV; t0 = 25; width = 1024; }
        else if (pn < 33) { off = WS_DZ; t0 = 29; width = 1024; act = 2; }
        else { const int g = (pn - 33) >> 2; off = WS_GATE + (size_t)g * MS * 1024 * 2; t0 = 33 + 4 * g; width = 1024; act = 3; }
        bf16* base = (bf16*)(ws + off) + (size_t)(u.pm * 256 + wr * 64 + fr) * width + (pn - t0) * 256 + wc * 32 + 8 * fq;
        if (act == 0) store<false>(acc, base, width, 0); else store<true>(acc, base, width, act);
    }
    template <bool ACT> static __device__ __forceinline__ void store(const pg8::f32x4 (&acc)[2][2][4][2], bf16* base, int width, int act) {
        const bool is_gelu = act == 1, is_sig = act == 3;
#pragma unroll
        for (int ai = 0; ai < 2; ++ai)
#pragma unroll
            for (int m = 0; m < 4; ++m) {
                bf16* p = base + (size_t)(ai * 128 + m * 16) * width;
#pragma unroll
                for (int bj = 0; bj < 2; ++bj) {
                    float h[8];
#pragma unroll
                    for (int n = 0; n < 2; ++n)
#pragma unroll
                        for (int e = 0; e < 4; ++e) { float v = acc[ai][bj][m][n][e];
                            if (ACT) { const float zg = 1.5957691216057308f * (v + 0.044715f * v * v * v); const float z = is_gelu ? zg : v; const float sg = fsigmoid(z); v = is_sig ? sg : v * sg; }
                            h[n * 4 + e] = v; }
                    v4u w; w.x = pk2(h[0], h[1]); w.y = pk2(h[2], h[3]); w.z = pk2(h[4], h[5]); w.w = pk2(h[6], h[7]);
                    *(v4u*)(p + bj * 128) = w;
                }
            }
    }
};
template <int BR> struct EpiMerge {
    static constexpr bool PERM = true, AFTER_DRAIN = false; const bf16* G; float* Ym; bf16* Y;
    __device__ __forceinline__ void operator()(const pg8::f32x4 (&acc)[2][2][4][2], const Unit& u, int wr, int wc, int fr, int fq) const {
        const int row0 = u.pm * 256 + wr * 64 + fr, col0 = u.pn * 256 + wc * 32 + 8 * fq;
#pragma unroll
        for (int ai = 0; ai < 2; ++ai)
#pragma unroll
            for (int m = 0; m < 4; ++m) {
                const size_t ro = (size_t)(row0 + ai * 128 + m * 16) * D + col0;
#pragma unroll
                for (int bj = 0; bj < 2; ++bj) {
                    const v4u g = *(const v4u*)(G + ro + bj * 128);
                    f32x4 a0 = acc[ai][bj][m][0], a1 = acc[ai][bj][m][1];
                    a0[0] *= bflo(g.x); a0[1] *= bfhi(g.x); a0[2] *= bflo(g.y); a0[3] *= bfhi(g.y);
                    a1[0] *= bflo(g.z); a1[1] *= bfhi(g.z); a1[2] *= bflo(g.w); a1[3] *= bfhi(g.w);
                    f32x4* q = (f32x4*)(Ym + ro + bj * 128);
                    if (BR >= 1) { a0 = a0 + q[0]; a1 = a1 + q[1]; }
                    if (BR <= 1) { q[0] = a0; q[1] = a1; }
                    else { v4u w; w.x = pk2(a0[0], a0[1]); w.y = pk2(a0[2], a0[3]); w.z = pk2(a1[0], a1[1]); w.w = pk2(a1[2], a1[3]); *(v4u*)(Y + ro + bj * 128) = w; }
                }
                asm volatile("" ::: "memory");
            }
    }
};

struct EpiPart {
    static constexpr bool PERM = true, AFTER_DRAIN = false; const bf16* G; bf16* P;
    __device__ __forceinline__ void operator()(const pg8::f32x4 (&acc)[2][2][4][2], const Unit& u, int wr, int wc, int fr, int fq) const {
        const int row0 = u.pm * 256 + wr * 64 + fr, col0 = u.pn * 256 + wc * 32 + 8 * fq;
#pragma unroll
        for (int ai = 0; ai < 2; ++ai)
#pragma unroll
            for (int m = 0; m < 4; ++m) {
                const size_t ro = (size_t)(row0 + ai * 128 + m * 16) * D + col0;
#pragma unroll
                for (int bj = 0; bj < 2; ++bj) {
                    const v4u g = *(const v4u*)(G + ro + bj * 128);
                    const f32x4 a0 = acc[ai][bj][m][0], a1 = acc[ai][bj][m][1];
                    v4u w; w.x = pk2(a0[0] * bflo(g.x), a0[1] * bfhi(g.x)); w.y = pk2(a0[2] * bflo(g.y), a0[3] * bfhi(g.y));
                    w.z = pk2(a1[0] * bflo(g.z), a1[1] * bfhi(g.z)); w.w = pk2(a1[2] * bflo(g.w), a1[3] * bfhi(g.w));
                    *(v4u*)(P + ro + bj * 128) = w;
                }
            }
    }
};

struct Ctx {
    LAS unsigned char* lds; unsigned char* ldsg;
    int tid, lane, wave, G, gw, NGW;
    unsigned char* ws; float* x;
};
__device__ __forceinline__ Ctx relaunder(const Ctx& C0) {
    Ctx R = C0; int t_ = C0.tid; unsigned long long w_ = (unsigned long long)C0.ws; asm volatile("" : "+v"(t_), "+s"(w_));
    R.tid = t_; R.lane = t_ & 63; R.wave = __builtin_amdgcn_readfirstlane(t_ >> 6); R.ws = (unsigned char*)(GAS unsigned char*)w_; return R;
}
constexpr int PTAB_OFF = 147456 - 512;
#define INP(i) (ld_inp(C, (i)))
__device__ __forceinline__ const float* ld_inp(const Ctx& C, int i) {
    const unsigned long long v = *(const LAS unsigned long long*)(C.lds + PTAB_OFF + 8 * i);
    const unsigned lo = __builtin_amdgcn_readfirstlane((unsigned)v), hi = __builtin_amdgcn_readfirstlane((unsigned)(v >> 32));
    return (const float*)(GAS const float*)(((unsigned long long)hi << 32) | lo);
}
struct TrIt { const float* W; bf16* WT; int ldw, K, k0, n0, drow0; };
__device__ __forceinline__ void tr_load(const TrIt& t, float (&tv)[32], int lane) {
#pragma unroll
    for (int i = 0; i < 32; ++i) tv[i] = t.W[(size_t)(t.k0 + 2 * i + (lane >> 5)) * t.ldw + t.n0 + (lane & 31)];
}
__device__ __forceinline__ void tr_finish(const TrIt& t, const float (&tv)[32], LAS float* scr, int lane) {
#pragma unroll
    for (int i = 0; i < 32; ++i) scr[(2 * i + (lane >> 5)) * 33 + (lane & 31)] = tv[i];
    LDS_WAIT(); asm volatile("" ::: "memory");
    const int c = lane & 7;
#pragma unroll
    for (int j = 0; j < 4; ++j) { const int n = (lane >> 3) + 8 * j; const LAS float* s = scr + (8 * c) * 33 + n;
        v4u o; o.x = pk2(s[0 * 33], s[1 * 33]); o.y = pk2(s[2 * 33], s[3 * 33]); o.z = pk2(s[4 * 33], s[5 * 33]); o.w = pk2(s[6 * 33], s[7 * 33]);
        *(v4u*)(t.WT + (size_t)(t.drow0 + n) * t.K + t.k0 + 8 * c) = o; }
    LDS_WAIT(); asm volatile("" ::: "memory");
}
template <class Dec> __device__ __forceinline__ void run_transposes(const Ctx& C, const Dec& dec, int nitems, LAS float* scr) {
    int it = C.gw; if (it >= nitems) return;
    TrIt cur = dec(it); float tv[32]; tr_load(cur, tv, C.lane);
    for (;;) {
        const int nx = it + C.NGW; const bool has = nx < nitems;
        TrIt nxt = dec(has ? nx : it); float tn[32];
        tr_load(nxt, tn, C.lane);
        tr_finish(cur, tv, scr, C.lane);
        if (!has) break;
        cur = nxt; it = nx;
#pragma unroll
        for (int i = 0; i < 32; ++i) tv[i] = tn[i];
    }
}
__device__ __forceinline__ void norm_rows(const Ctx& C, const float* g, bf16* XN, const LAS float* Wl, float* BA) {
    f32x4 gv[4];
#pragma unroll
    for (int j = 0; j < 4; ++j) gv[j] = *((const f32x4*)g + C.lane + 64 * j);
    f32x4 vn[2][4];
#pragma unroll
    for (int rr = 0; rr < 2; ++rr) { const int m = min(C.gw + rr * C.NGW, M - 1); const f32x4* xr = (const f32x4*)(C.x + (size_t)m * D) + C.lane;
#pragma unroll
        for (int j = 0; j < 4; ++j) vn[rr][j] = xr[64 * j]; }
    for (int m0 = C.gw; m0 < M; m0 += 2 * C.NGW) {
        f32x4 v[2][4]; float s[2] = {0.f, 0.f};
#pragma unroll
        for (int rr = 0; rr < 2; ++rr)
#pragma unroll
            for (int j = 0; j < 4; ++j) v[rr][j] = vn[rr][j];
#pragma unroll
        for (int rr = 0; rr < 2; ++rr) { const int m = min(m0 + (2 + rr) * C.NGW, M - 1); const f32x4* xr = (const f32x4*)(C.x + (size_t)m * D) + C.lane;
#pragma unroll
            for (int j = 0; j < 4; ++j) vn[rr][j] = xr[64 * j]; }
#pragma unroll
        for (int rr = 0; rr < 2; ++rr) { const int m = m0 + rr * C.NGW; if (m >= M) break;
#pragma unroll
            for (int j = 0; j < 4; ++j) s[rr] += (v[rr][j].x * v[rr][j].x + v[rr][j].y * v[rr][j].y) + (v[rr][j].z * v[rr][j].z + v[rr][j].w * v[rr][j].w);
            const float rstd = rsqrtf(wave_sum(s[rr]) * (1.f / D) + EPS);
            unsigned long long* o8 = (unsigned long long*)(XN + (size_t)m * D) + C.lane;
#pragma unroll
            for (int j = 0; j < 4; ++j) { v[rr][j] = v[rr][j] * rstd * gv[j]; o8[64 * j] = (unsigned long long)pk2(v[rr][j].x, v[rr][j].y) | ((unsigned long long)pk2(v[rr][j].z, v[rr][j].w) << 32); }
            if (BA) {
                asm volatile("" ::: "memory");
                float mine = 0.f;
#pragma unroll
                for (int c = 0; c < 16; ++c) {
                    float a = 0.f;
#pragma unroll
                    for (int j = 0; j < 4; ++j) { const f32x4 w = *((const LAS f32x4*)(Wl + c * 1024) + C.lane + 64 * j); a += (v[rr][j].x * w.x + v[rr][j].y * w.y) + (v[rr][j].z * w.z + v[rr][j].w * w.w); }
                    const float t = wave_sum(a); if (C.lane == c) mine = t;
                }
                if (C.lane < 16) BA[(size_t)m * 16 + C.lane] = mine;
            }
        }
    }
}
__device__ __forceinline__ void prep_ffn(const Ctx& C, const float* Wg, const float* Wu, const float* Wd, const float* gn) {
    LAS float* scr = (LAS float*)(C.lds + C.wave * 16384);
    bf16* W1T = (bf16*)(C.ws + WS_W1T); bf16* W2T = (bf16*)(C.ws + WS_W2T);
    constexpr int I1 = (D / 64) * (FF / 32), I2 = (FF / 64) * (D / 32);
    auto dec = [=](int it) -> TrIt {
        int r = it; TrIt t;
        if (r < 2 * I1) { const int up = r >= I1; if (up) r -= I1; const int kb = r / (FF / 32), nb = r % (FF / 32), n0 = 32 * nb;
            t.W = up ? Wu : Wg; t.WT = W1T; t.ldw = FF; t.K = D; t.k0 = 64 * kb; t.n0 = n0; t.drow0 = 256 * (n0 >> 7) + 128 * up + (n0 & 127); }
        else { r -= 2 * I1; const int kb = r / (D / 32), nb = r % (D / 32); t.W = Wd; t.WT = W2T; t.ldw = D; t.K = FF; t.k0 = 64 * kb; t.n0 = 32 * nb; t.drow0 = 32 * nb; }
        return t; };
    run_transposes(C, dec, 2 * I1 + I2, scr);
    norm_rows(C, gn, (bf16*)(C.ws + WS_XN), nullptr, nullptr);
}
__device__ __forceinline__ void prep_mix(const Ctx& C, const float* Win, const float* Wbr, const float* Wout, const float* gn) {
    LAS float* scr = (LAS float*)(C.lds + C.wave * 16384);
    constexpr int NB_IN = NPROJ / 32, I_IN = 16 * NB_IN, I_A = 16 * 32, I_B = 12 * 32, I_C = 16 * 32, I_O = 16 * 32;
    unsigned char* ws_ = C.ws;
    auto dec = [=](int it) -> TrIt {
        int r = it; TrIt t;
        if (r < I_IN) { const int kb = r / NB_IN, nb = r % NB_IN; const int drow = 32 * nb, n0 = drow < 8448 ? drow : drow + 16;
            t.W = Win; t.WT = (bf16*)(ws_ + WS_WINT); t.ldw = IN_DIM; t.K = D; t.k0 = 64 * kb; t.n0 = n0; t.drow0 = drow; return t; }
        r -= I_IN; t.ldw = D; t.k0 = 64 * (r / 32); t.n0 = 32 * (r % 32); t.drow0 = t.n0;
        if (r < I_A) { t.W = Wbr; t.WT = (bf16*)(ws_ + WS_WBA); t.K = 1024; return t; } r -= I_A; t.k0 = 64 * (r / 32); t.n0 = 32 * (r % 32); t.drow0 = t.n0;
        if (r < I_B) { t.W = Wbr + (size_t)1024 * D; t.WT = (bf16*)(ws_ + WS_WBB); t.K = 768; return t; } r -= I_B; t.k0 = 64 * (r / 32); t.n0 = 32 * (r % 32); t.drow0 = t.n0;
        if (r < I_C) { t.W = Wbr + (size_t)1792 * D; t.WT = (bf16*)(ws_ + WS_WBC); t.K = 1024; return t; } r -= I_C; t.k0 = 64 * (r / 32); t.n0 = 32 * (r % 32); t.drow0 = t.n0;
        t.W = Wout; t.WT = (bf16*)(ws_ + WS_WOUT); t.K = 1024; return t; };
    run_transposes(C, dec, I_IN + I_A + I_B + I_C + I_O, scr);
    __syncthreads();
    LAS float* Wl = (LAS float*)C.lds;
    for (int idx = C.tid; idx < 16 * 1024; idx += NTHREADS) { const int k = idx >> 4, c = idx & 15; Wl[c * 1024 + k] = Win[(size_t)k * IN_DIM + 8448 + c]; }
    __syncthreads();
    norm_rows(C, gn, (bf16*)(C.ws + WS_XN), Wl, (float*)(C.ws + WS_BA));
    __syncthreads();
}

template <int S> __device__ __forceinline__ float dpp_shr(float old, float v) {
    return __builtin_bit_cast(float, __builtin_amdgcn_update_dpp(__builtin_bit_cast(int, old), __builtin_bit_cast(int, v), 0x110 + S, 0xf, 0xf, false));
}
__device__ __forceinline__ float pm1(float y) {
    const float p = y * (1.f + y * (0.5f + y * (1.f / 6.f + y * (1.f / 24.f + y * (1.f / 120.f + y * (1.f / 720.f + y * (1.f / 5040.f)))))));
    if (__builtin_expect(__any(fabsf(y) >= 0.35f), 0)) return fabsf(y) < 0.35f ? p : __expf(y) - 1.f;
    return p;
}
__device__ __forceinline__ bf16x8 pack8(const float* v) {
    v4u w; w.x = pk2(v[0], v[1]); w.y = pk2(v[2], v[3]); w.z = pk2(v[4], v[5]); w.w = pk2(v[6], v[7]); return __builtin_bit_cast(bf16x8, w);
}
__device__ __forceinline__ void unpack8(v4u w, float* v) {
    v[0] = bflo(w.x); v[1] = bfhi(w.x); v[2] = bflo(w.y); v[3] = bfhi(w.y); v[4] = bflo(w.z); v[5] = bfhi(w.z); v[6] = bflo(w.w); v[7] = bfhi(w.w);
}
constexpr size_t WS_RGS = WS_LSE + 512 * 1024;
__device__ __forceinline__ float swz_row15(float v) { return __builtin_bit_cast(float, __builtin_amdgcn_ds_swizzle(__builtin_bit_cast(int, v), 0x1F0)); }
template <int PASS> __device__ __forceinline__ void rg_item(const Ctx& C0, int l, int bl, int n, int half) {
    const Ctx C = relaunder(C0);
    const int lane = C.lane, wave = C.wave, fr = lane & 15, fq = lane >> 4;
    const size_t base = (size_t)bl * SEQ * 1024 + n * 64;
    const bf16* X = (const bf16*)(C.ws + WS_RGX) + base; const bf16* Gt = (const bf16*)(C.ws + WS_RGG) + base; bf16* YA = (bf16*)(C.ws + WS_YA) + base;
    float* RGS = (float*)(C.ws + WS_RGS) + (size_t)(bl * 16 + n) * 16 * 128;
    LAS float* ctab = (LAS float*)C.lds;
    LAS float* Wl = (LAS float*)(C.lds + 2048);
    LAS bf16x8* Afr = (LAS bf16x8*)(C.lds + 2048 + 32768);
    __syncthreads();
    {   const int t = C.tid;
        if (t < 64) { const int ch = n * 64 + t;
#pragma unroll
            for (int k = 0; k < 4; ++k) ctab[k * 64 + t] = INP(7)[(size_t)l * 4096 + k * 1024 + ch];
            ctab[4 * 64 + t] = INP(8)[l * 1024 + ch]; ctab[5 * 64 + t] = INP(10)[l * 1024 + ch]; ctab[6 * 64 + t] = INP(12)[l * 1024 + ch];
            ctab[7 * 64 + t] = fsoftplus(-INP(13)[l * 1024 + ch]); }
        const float* wr_ = INP(9) + (size_t)l * 65536 + n * 4096; const float* wi_ = INP(11) + (size_t)l * 65536 + n * 4096;
        for (int i = t; i < 4096; i += NTHREADS) { Wl[i] = wr_[i]; Wl[4096 + i] = wi_[i]; }
    }
    __syncthreads();
#pragma unroll
    for (int q2 = 0; q2 < 2; ++q2) {
        const int combo = wave * 2 + q2, gate_ = combo >> 3, mt = (combo >> 1) & 3, ks = combo & 1;
        const int d = (mt >> 1) * 32 + (fr >> 2) * 8 + (mt & 1) * 4 + (fr & 3); float a[8];
#pragma unroll
        for (int i = 0; i < 8; ++i) { const int c = ks * 32 + fq * 8 + i; a[i] = Wl[gate_ * 4096 + c * 64 + d]; }
        Afr[combo * 64 + lane] = pack8(a);
    }
    __syncthreads();
    const int seg = half * 8 + wave;
    float cA[16], cB[16];
#pragma unroll
    for (int i = 0; i < 16; ++i) { cA[i] = 1.f; cB[i] = 0.f; }
    if (PASS == 1) {
        for (int s2 = 0; s2 < seg; ++s2) {
            const f32x4* sp = (const f32x4*)(RGS + (s2 * 4 + fq) * 32);
#pragma unroll
            for (int i = 0; i < 8; ++i) { const f32x4 v = sp[i]; cB[2 * i] = v.x * cB[2 * i] + v.y; cB[2 * i + 1] = v.z * cB[2 * i + 1] + v.w; }
        }
    }
    v4u raw[2][4];
    {   const int t = seg * 128 + fr;
#pragma unroll
        for (int s_ = 0; s_ < 2; ++s_)
#pragma unroll
            for (int k = 0; k < 4; ++k) { const int tt = t - 3 + k; raw[s_][k] = (v4u){0u, 0u, 0u, 0u}; if (tt >= 0) raw[s_][k] = *(const v4u*)(X + (size_t)tt * 1024 + s_ * 32 + fq * 8); }
    }
#pragma unroll 1
    for (int tile = 0; tile < 8; ++tile) {
        asm volatile("" ::: "memory");
        const int t = seg * 128 + tile * 16 + fr;
        v4u cur[2][4];
#pragma unroll
        for (int s_ = 0; s_ < 2; ++s_)
#pragma unroll
            for (int k = 0; k < 4; ++k) cur[s_][k] = raw[s_][k];
        if (tile + 1 < 8) {
#pragma unroll
            for (int s_ = 0; s_ < 2; ++s_)
#pragma unroll
                for (int k = 0; k < 4; ++k) raw[s_][k] = *(const v4u*)(X + (size_t)(t + 16 - 3 + k) * 1024 + s_ * 32 + fq * 8);
        }
        v4u graw[2];
        if (PASS == 1) {
#pragma unroll
            for (int s_ = 0; s_ < 2; ++s_) graw[s_] = *(const v4u*)(Gt + (size_t)t * 1024 + s_ * 32 + fq * 8);
        }
        float xa[16];
#pragma unroll
        for (int s_ = 0; s_ < 2; ++s_) {
            const int ch0 = s_ * 32 + fq * 8; float acc8[8];
            { const f32x4 c0 = *(const LAS f32x4*)(ctab + 4 * 64 + ch0), c1 = *(const LAS f32x4*)(ctab + 4 * 64 + ch0 + 4);
              acc8[0] = c0.x; acc8[1] = c0.y; acc8[2] = c0.z; acc8[3] = c0.w; acc8[4] = c1.x; acc8[5] = c1.y; acc8[6] = c1.z; acc8[7] = c1.w; }
#pragma unroll
            for (int k = 0; k < 4; ++k) {
                float xv[8]; unpack8(cur[s_][k], xv);
                const f32x4 w0 = *(const LAS f32x4*)(ctab + k * 64 + ch0), w1 = *(const LAS f32x4*)(ctab + k * 64 + ch0 + 4);
                acc8[0] += w0.x * xv[0]; acc8[1] += w0.y * xv[1]; acc8[2] += w0.z * xv[2]; acc8[3] += w0.w * xv[3];
                acc8[4] += w1.x * xv[4]; acc8[5] += w1.y * xv[5]; acc8[6] += w1.z * xv[6]; acc8[7] += w1.w * xv[7];
            }
#pragma unroll
            for (int e = 0; e < 8; ++e) xa[s_ * 8 + e] = acc8[e];
        }
        bf16x8 Bop[2]; Bop[0] = pack8(xa); Bop[1] = pack8(xa + 8);
        f32x4 ar[4], ai[4];
#pragma unroll
        for (int mt = 0; mt < 4; ++mt) {
            ar[mt] = (f32x4){0.f, 0.f, 0.f, 0.f}; ai[mt] = (f32x4){0.f, 0.f, 0.f, 0.f};
#pragma unroll
            for (int ks = 0; ks < 2; ++ks) { ar[mt] = __builtin_amdgcn_mfma_f32_16x16x32_bf16(Afr[(mt * 2 + ks) * 64 + lane], Bop[ks], ar[mt], 0, 0, 0); ai[mt] = __builtin_amdgcn_mfma_f32_16x16x32_bf16(Afr[(8 + mt * 2 + ks) * 64 + lane], Bop[ks], ai[mt], 0, 0, 0); }
        }
        float gate[16], hout[16];
        if (PASS == 1) { unpack8(graw[0], gate); unpack8(graw[1], gate + 8); }
        f32x4 cbr[4], cbi[4], csp[4];
#pragma unroll
        for (int mt = 0; mt < 4; ++mt) { const int ch0 = (mt >> 1) * 32 + fq * 8 + (mt & 1) * 4;
            cbr[mt] = *(const LAS f32x4*)(ctab + 5 * 64 + ch0); cbi[mt] = *(const LAS f32x4*)(ctab + 6 * 64 + ch0); csp[mt] = *(const LAS f32x4*)(ctab + 7 * 64 + ch0); }
#pragma unroll
        for (int mt = 0; mt < 4; ++mt)
#pragma unroll
            for (int j = 0; j < 4; ++j) {
                const int ci = (mt >> 1) * 8 + (mt & 1) * 4 + j;
                const float r = fsigmoid(ar[mt][j] + cbr[mt][j]), ig = fsigmoid(ai[mt][j] + cbi[mt][j]);
                const float la = -8.f * r * csp[mt][j];
                const float p1 = pm1(la);
                float A = 1.f + p1; float B = __builtin_amdgcn_sqrtf(fmaxf(-p1 * (p1 + 2.f), 0.f)) * (ig * xa[ci]);
                { float Ap = dpp_shr<1>(1.f, A), Bp = dpp_shr<1>(0.f, B); B = A * Bp + B; A = A * Ap; }
                { float Ap = dpp_shr<2>(1.f, A), Bp = dpp_shr<2>(0.f, B); B = A * Bp + B; A = A * Ap; }
                { float Ap = dpp_shr<4>(1.f, A), Bp = dpp_shr<4>(0.f, B); B = A * Bp + B; A = A * Ap; }
                { float Ap = dpp_shr<8>(1.f, A), Bp = dpp_shr<8>(0.f, B); B = A * Bp + B; A = A * Ap; }
                if (PASS == 0) {
                    const float A15 = swz_row15(A), B15 = swz_row15(B);
                    cB[ci] = A15 * cB[ci] + B15; cA[ci] = A15 * cA[ci];
                } else {
                    const float h = B + A * cB[ci];
                    cB[ci] = swz_row15(h);
                    hout[ci] = h * gate[ci];
                }
            }
        if (PASS == 1) {
#pragma unroll
            for (int s_ = 0; s_ < 2; ++s_) *(bf16x8*)(YA + (size_t)t * 1024 + s_ * 32 + fq * 8) = pack8(hout + s_ * 8);
        }
    }
    if (PASS == 0 && fr == 0) {
        f32x4* sp = (f32x4*)(RGS + (seg * 4 + fq) * 32);
#pragma unroll
        for (int i = 0; i < 8; ++i) sp[i] = (f32x4){cA[2 * i], cB[2 * i], cA[2 * i + 1], cB[2 * i + 1]};
    }
}

__device__ __forceinline__ void attn_item(const Ctx& C0, int l, int bl, int h, int blk) {
    const Ctx C = relaunder(C0);
    const int lane = C.lane, wave = C.wave, fr = lane & 15, fq = lane >> 4, tid = C.tid;
    const int g = h >> 2, dil = g == 0 ? 1 : (g == 1 ? 4 : 16);
    const int r = g == 0 ? 0 : (g == 1 ? (blk >> 2) : blk), nb = g == 0 ? blk : (g == 1 ? (blk & 3) : 0);
    const bf16* Q = (const bf16*)(C.ws + WS_AQ) + (size_t)bl * SEQ * ATT_W + h * 64;
    const bf16* K = (const bf16*)(C.ws + WS_AK) + (size_t)bl * SEQ * ATT_W + h * 64;
    const bf16* V = (const bf16*)(C.ws + WS_AV) + (size_t)bl * SEQ * ATT_W + h * 64;
    bf16* O = (bf16*)(C.ws + WS_YB) + (size_t)bl * SEQ * ATT_W + h * 64;
    float* LSE = (float*)(C.ws + WS_LSE) + (size_t)bl * SEQ * 12 + h;
    LAS bf16* VT = (LAS bf16*)C.lds;
    LAS bf16* Pw = (LAS bf16*)(C.lds + 64 * 264 * 2) + wave * (16 * 168);
    const float slope = exp2f(-8.f * (float)(h + 1) / 12.f) * (float)dil;
    __syncthreads();
    {
        const int key = tid & 255, half = tid >> 8; int lsub = (nb - 1) * 128 + key; if (lsub < 0) lsub = 0;
        const size_t t = (size_t)lsub * dil + r;
#pragma unroll
        for (int c = 0; c < 4; ++c) { const v4u raw = *(const v4u*)(V + t * ATT_W + half * 32 + c * 8); const int d0 = half * 32 + c * 8;
            VT[(d0 + 0) * 264 + key] = (bf16)(raw.x & 0xffff); VT[(d0 + 1) * 264 + key] = (bf16)(raw.x >> 16); VT[(d0 + 2) * 264 + key] = (bf16)(raw.y & 0xffff); VT[(d0 + 3) * 264 + key] = (bf16)(raw.y >> 16);
            VT[(d0 + 4) * 264 + key] = (bf16)(raw.z & 0xffff); VT[(d0 + 5) * 264 + key] = (bf16)(raw.z >> 16); VT[(d0 + 6) * 264 + key] = (bf16)(raw.w & 0xffff); VT[(d0 + 7) * 264 + key] = (bf16)(raw.w >> 16); }
        if (tid < 64) { for (int c = 256; c < 264; ++c) VT[tid * 264 + c] = 0; }
    }
    bf16x8 Aq[2];
    {   const size_t t = (size_t)(nb * 128 + wave * 16 + fr) * dil + r; float v[16]; float ss = 0.f;
#pragma unroll
        for (int ks = 0; ks < 2; ++ks) { const v4u raw = *(const v4u*)(Q + t * ATT_W + ks * 32 + fq * 8); unpack8(raw, v + ks * 8); }
#pragma unroll
        for (int i = 0; i < 16; ++i) ss += v[i] * v[i];
        ss += __shfl_xor(ss, 16); ss += __shfl_xor(ss, 32);
        const float rs = rsqrtf(ss * (1.f / 64.f) + EPS) * 0.125f;
#pragma unroll
        for (int ks = 0; ks < 2; ++ks) {
#pragma unroll
            for (int i = 0; i < 8; ++i) v[ks * 8 + i] *= rs * INP(14)[l * 768 + h * 64 + ks * 32 + fq * 8 + i];
            Aq[ks] = pack8(v + ks * 8); }
    }
    float gk[16];
#pragma unroll
    for (int ks = 0; ks < 2; ++ks)
#pragma unroll
        for (int i = 0; i < 8; ++i) gk[ks * 8 + i] = INP(15)[l * 768 + h * 64 + ks * 32 + fq * 8 + i];
    f32x4 sacc[9]; float mx[4];
#pragma unroll
    for (int j = 0; j < 4; ++j) mx[j] = -1e30f;
#pragma unroll
    for (int kk = 0; kk < 9; ++kk) {
        const int kt = wave + kk; int kj = kt * 16 + fr; int lsub = (nb - 1) * 128 + kj; if (lsub < 0) lsub = 0;
        if (nb == 0 && kt < 8) { sacc[kk] = (f32x4){-1e30f, -1e30f, -1e30f, -1e30f}; continue; }
        const size_t t = (size_t)lsub * dil + r; float v[16]; float ss = 0.f;
#pragma unroll
        for (int ks = 0; ks < 2; ++ks) { const v4u raw = *(const v4u*)(K + t * ATT_W + ks * 32 + fq * 8); unpack8(raw, v + ks * 8); }
#pragma unroll
        for (int i = 0; i < 16; ++i) ss += v[i] * v[i];
        ss += __shfl_xor(ss, 16); ss += __shfl_xor(ss, 32);
        const float rs = rsqrtf(ss * (1.f / 64.f) + EPS);
#pragma unroll
        for (int i = 0; i < 16; ++i) v[i] *= rs * gk[i];
        f32x4 s = (f32x4){0.f, 0.f, 0.f, 0.f};
        s = __builtin_amdgcn_mfma_f32_16x16x32_bf16(Aq[0], pack8(v), s, 0, 0, 0);
        s = __builtin_amdgcn_mfma_f32_16x16x32_bf16(Aq[1], pack8(v + 8), s, 0, 0, 0);
#pragma unroll
        for (int j = 0; j < 4; ++j) {
            const int delta = wave * 16 + fq * 4 + j + 128 - kj;
            const bool valid = delta >= 0 && delta <= 128 && (nb > 0 || kj >= 128);
            s[j] = valid ? s[j] - slope * (float)delta : -1e30f;
            mx[j] = fmaxf(mx[j], s[j]);
        }
        sacc[kk] = s;
    }
    float den[4];
#pragma unroll
    for (int j = 0; j < 4; ++j) { mx[j] = row16_max(mx[j]); den[j] = 0.f; }
#pragma unroll
    for (int kk = 0; kk < 9; ++kk)
#pragma unroll
        for (int j = 0; j < 4; ++j) { const float p = __expf(sacc[kk][j] - mx[j]); den[j] += p; Pw[(fq * 4 + j) * 168 + kk * 16 + fr] = (bf16)f2bf(p); }
    if (fr < 8) {
#pragma unroll
        for (int j = 0; j < 4; ++j) { Pw[(fq * 4 + j) * 168 + 144 + fr] = 0; Pw[(fq * 4 + j) * 168 + 152 + fr] = 0; }
    }
#pragma unroll
    for (int j = 0; j < 4; ++j) { den[j] = row16_sum(den[j]); }
    __syncthreads();
    f32x4 oacc[4];
#pragma unroll
    for (int nt = 0; nt < 4; ++nt) oacc[nt] = (f32x4){0.f, 0.f, 0.f, 0.f};
#pragma unroll
    for (int ks = 0; ks < 5; ++ks) {
        if (nb == 0 && wave + 2 * ks + 1 < 8) continue;
        const bf16x8 pa = *(const LAS bf16x8*)(Pw + fr * 168 + ks * 32 + fq * 8);
        int kb = wave * 16 + ks * 32 + fq * 8; if (kb > 256) kb = 256;
#pragma unroll
        for (int nt = 0; nt < 4; ++nt) { const bf16x8 vb = *(const LAS bf16x8*)(VT + (nt * 16 + fr) * 264 + kb); oacc[nt] = __builtin_amdgcn_mfma_f32_16x16x32_bf16(pa, vb, oacc[nt], 0, 0, 0); }
    }
#pragma unroll
    for (int j = 0; j < 4; ++j) {
        const size_t t = (size_t)(nb * 128 + wave * 16 + fq * 4 + j) * dil + r; const float inv = 1.f / den[j];
#pragma unroll
        for (int nt = 0; nt < 4; ++nt) O[t * ATT_W + nt * 16 + fr] = (bf16)f2bf(oacc[nt][j] * inv);
        if (fr == 0) LSE[t * 12] = mx[j] + __logf(den[j]);
    }
}
__device__ __forceinline__ void attn_fix(const Ctx& C, int bx, int first_block, int nblocks) {
    const bf16* dummy = nullptr; (void)dummy;
    bf16* Y = (bf16*)(C.ws + WS_YB); const float* LSE = (const float*)(C.ws + WS_LSE);
    const size_t total = (size_t)MS * 96, stride = (size_t)nblocks * NTHREADS;
    for (size_t i = (size_t)(bx - first_block) * NTHREADS + C.tid; i < total; i += stride) {
        const size_t row = i / 96; const int c = (int)(i % 96), head = c >> 3, g = head >> 2, j = head & 3;
        const float l0 = LSE[row * 12 + j], l1 = LSE[row * 12 + 4 + j], l2 = LSE[row * 12 + 8 + j];
        const float m = fmaxf(l0, fmaxf(l1, l2)); const float e0 = __expf(l0 - m), e1 = __expf(l1 - m), e2 = __expf(l2 - m);
        const float w = (g == 0 ? e0 : (g == 1 ? e1 : e2)) / (e0 + e1 + e2);
        v4u* p = (v4u*)(Y + row * ATT_W + c * 8); const v4u raw = *p; float v[8]; unpack8(raw, v);
#pragma unroll
        for (int e = 0; e < 8; ++e) v[e] *= w;
        *p = __builtin_bit_cast(v4u, pack8(v));
    }
}

constexpr int DL_KH = 0, DL_QH = 17408, DL_VB = 34816, DL_KB = 52480, DL_KD = 70144, DL_XRM = 87808, DL_PT = 97024, DL_PRM = 106240, DL_SET2 = 27648, DL_TAB = 115456 + 27648, DL_RS = 138;
__device__ __forceinline__ int permc(int c) { return (c & 32) + ((c & 15) >> 2) * 8 + ((c >> 4) & 1) * 4 + (c & 3); }
#define MFMA16(a, b, c) __builtin_amdgcn_mfma_f32_16x16x32_bf16(a, b, c, 0, 0, 0)
__device__ __forceinline__ void st_wt8(void* p, unsigned lo, unsigned hi) { __hip_atomic_store((GAS unsigned long long*)p, ((unsigned long long)hi << 32) | lo, __ATOMIC_RELAXED, __HIP_MEMORY_SCOPE_AGENT); }
__device__ __forceinline__ void st_wt2(void* p, unsigned v) { __hip_atomic_store((GAS unsigned short*)p, (unsigned short)v, __ATOMIC_RELAXED, __HIP_MEMORY_SCOPE_AGENT); }
__device__ __forceinline__ void dn_local_item(const Ctx& C0, int l, int s, int bl, int h, int chunk) {
    const Ctx C = relaunder(C0);
    const int lane = C.lane, wave = C.wave, fr = lane & 15, fq = lane >> 4, tid = C.tid;
    LAS bf16* Kh = (LAS bf16*)(C.lds + DL_KH); LAS bf16* Qh = (LAS bf16*)(C.lds + DL_QH); LAS bf16* Vb = (LAS bf16*)(C.lds + DL_VB); LAS bf16* Kb = (LAS bf16*)(C.lds + DL_KB);
    LAS bf16* Kd = (LAS bf16*)(C.lds + DL_KD); LAS bf16* Xrm = (LAS bf16*)(C.lds + DL_XRM); LAS bf16* PT = (LAS bf16*)(C.lds + DL_PT); LAS bf16* Prm = (LAS bf16*)(C.lds + DL_PRM);
    LAS float* gamT = (LAS float*)(C.lds + DL_TAB); LAS float* betT = gamT + 64;
    const int item = (bl * 8 + h) * 32 + chunk;
    const size_t rl0 = (size_t)bl * SEQ + chunk * 64;
    const size_t rg0 = (size_t)s * MS + rl0;
    float* U0T = (float*)(C.ws + WS_U0T) + (size_t)item * 8192; bf16* WK = (bf16*)(C.ws + WS_WK) + (size_t)item * 8192; bf16* QD = (bf16*)(C.ws + WS_QD) + (size_t)item * 8192;
    bf16* KDT = (bf16*)(C.ws + WS_KDT) + (size_t)item * 8192; bf16* QK = (bf16*)(C.ws + WS_QK) + (size_t)item * 4096;
    __syncthreads();
    float gam_last;
    {   const float* ba = (const float*)(C.ws + WS_BA) + (rg0 + lane) * 16;
        const float beta = fsigmoid(ba[h]);
        const float gl = -expf(INP(17)[l * 8 + h]) * fsoftplus(ba[8 + h] + INP(18)[l * 8 + h]);
        float gm = gl;
#pragma unroll
        for (int o = 1; o < 64; o <<= 1) { const float t = __shfl_up(gm, o); if (lane >= o) gm += t; }
        gamT[lane] = gm; betT[lane] = beta; gam_last = __shfl(gm, 63);
        LDS_WAIT();
    }
    {   const int rp = fq, cg = fr;
        const int tc0 = chunk * 64 + wave * 8 + rp * 2;
#pragma unroll
        for (int sec = 0; sec < 3; ++sec) {
            const bf16* src = (const bf16*)(C.ws + (sec == 0 ? WS_DQ : (sec == 1 ? WS_DK : WS_DV))) + h * 128 + cg * 8;
            v4u rawr[5];
#pragma unroll
            for (int k = 0; k < 5; ++k) { const int tt = tc0 - 3 + k; rawr[k] = (v4u){0u, 0u, 0u, 0u}; if (tt >= 0) rawr[k] = *(const v4u*)(src + ((size_t)bl * SEQ + tt) * 1024); }
            float w[4][8];
#pragma unroll
            for (int k = 0; k < 4; ++k) { const f32x4* wp = (const f32x4*)(INP(16) + (size_t)l * 12288 + k * 3072 + sec * 1024 + h * 128 + cg * 8); const f32x4 a = wp[0], b = wp[1];
                w[k][0] = a.x; w[k][1] = a.y; w[k][2] = a.z; w[k][3] = a.w; w[k][4] = b.x; w[k][5] = b.y; w[k][6] = b.z; w[k][7] = b.w; }
#pragma unroll
            for (int rr = 0; rr < 2; ++rr) {
                const int r = wave * 8 + rp * 2 + rr;
                float xw[4][8];
#pragma unroll
                for (int k = 0; k < 4; ++k) unpack8(rawr[rr + k], xw[k]);
                float val[8]; float ss = 0.f;
#pragma unroll
                for (int e = 0; e < 8; ++e) { const float a = w[0][e] * xw[0][e] + w[1][e] * xw[1][e] + w[2][e] * xw[2][e] + w[3][e] * xw[3][e]; val[e] = fsilu(a); ss += val[e] * val[e]; }
                ss = row16_sum(ss);
                const float rn = rsqrtf(ss + EPS), gm = gamT[r], bt = betT[r];
                if (sec == 0) {
                    float qh[8], qd[8]; const float eg = __expf(gm);
#pragma unroll
                    for (int e = 0; e < 8; ++e) { qh[e] = val[e] * rn * 0.08838834764831845f; qd[e] = qh[e] * eg; }
                    *(LAS bf16x8*)(Qh + r * 136 + cg * 8) = pack8(qh);
                    const int c0 = cg * 8, p0 = (c0 & ~31) + ((c0 & 15) >> 2) * 8 + ((c0 >> 4) & 1) * 4;
                    v2u a; a.x = pk2(qd[0], qd[1]); a.y = pk2(qd[2], qd[3]); v2u b; b.x = pk2(qd[4], qd[5]); b.y = pk2(qd[6], qd[7]);
                    { const int fi = ((r >> 4) * 4 + (p0 >> 5)) * 64 + ((p0 & 31) >> 3) * 16 + (r & 15);
                      *(v2u*)(QD + fi * 8 + (p0 & 7)) = a; *(v2u*)(QD + (fi + 16) * 8 + (p0 & 7)) = b; }
                } else if (sec == 1) {
                    float kh[8]; const float eb = bt * __expf(gm), ed = __expf(gam_last - gm);
#pragma unroll
                    for (int e = 0; e < 8; ++e) kh[e] = val[e] * rn;
                    *(LAS bf16x8*)(Kh + r * 136 + cg * 8) = pack8(kh);
                    LAS unsigned* pb = (LAS unsigned*)(Kb + r * DL_RS + cg * 8); LAS unsigned* pd = (LAS unsigned*)(Kd + r * DL_RS + cg * 8);
#pragma unroll
                    for (int e = 0; e < 4; ++e) { pb[e] = pk2(kh[2 * e] * eb, kh[2 * e + 1] * eb); pd[e] = pk2(kh[2 * e] * ed, kh[2 * e + 1] * ed); }
                } else {
                    LAS unsigned* pv = (LAS unsigned*)(Vb + r * DL_RS + cg * 8);
#pragma unroll
                    for (int e = 0; e < 4; ++e) pv[e] = pk2(val[2 * e] * bt, val[2 * e + 1] * bt);
                }
            }
        }
    }
    __syncthreads();
    f32x4 Xacc[2];
#pragma unroll
    for (int q = 0; q < 2; ++q) {
        const int p = wave + 8 * q, mt = p >> 2, nt = p & 3;
        f32x4 kk = (f32x4){0.f, 0.f, 0.f, 0.f}, qq = (f32x4){0.f, 0.f, 0.f, 0.f};
        if (nt <= mt) {
#pragma unroll
            for (int ks = 0; ks < 4; ++ks) {
                const bf16x8 a = *(const LAS bf16x8*)(Kh + (mt * 16 + fr) * 136 + ks * 32 + fq * 8), aq = *(const LAS bf16x8*)(Qh + (mt * 16 + fr) * 136 + ks * 32 + fq * 8);
                const bf16x8 b = *(const LAS bf16x8*)(Kh + (nt * 16 + fr) * 136 + ks * 32 + fq * 8);
                kk = MFMA16(a, b, kk); qq = MFMA16(aq, b, qq);
            }
        }
        const int jj = nt * 16 + fr; const float gj = gamT[jj];
        f32x4 xa;
#pragma unroll
        for (int j = 0; j < 4; ++j) {
            const int i = mt * 16 + fq * 4 + j; const float dec = (jj <= i) ? __expf(gamT[i] - gj) : 0.f;
            const float Aij = (jj < i) ? betT[i] * kk[j] * dec : 0.f; const float qk = (jj <= i) ? qq[j] * dec : 0.f;
            xa[j] = (i == jj ? 1.f : 0.f) - Aij;
            Xrm[i * 72 + jj] = (bf16)f2bf(xa[j]); Prm[i * 72 + jj] = (bf16)f2bf(Aij); PT[jj * 72 + i] = (bf16)f2bf(Aij);
            { const int pj = permc(jj); QK[(((i >> 4) * 2 + (pj >> 5)) * 64 + ((pj & 31) >> 3) * 16 + (i & 15)) * 8 + (pj & 7)] = (bf16)f2bf(qk); }
        }
        Xacc[q] = xa;
    }
    __syncthreads();
#pragma unroll
    for (int q = 0; q < 2; ++q) {
        const int p = wave + 8 * q, mt = p >> 2, nt = p & 3;
        if (nt > mt) {
            const int jj = nt * 16 + fr;
#pragma unroll
            for (int j = 0; j < 4; ++j) { const int i = mt * 16 + fq * 4 + j; (Xrm + DL_SET2 / 2)[i * 72 + jj] = 0; (Prm + DL_SET2 / 2)[i * 72 + jj] = 0; (PT + DL_SET2 / 2)[jj * 72 + i] = 0; }
        }
    }
#pragma unroll 1
    for (int st = 0; st < 6; ++st) {
        LAS bf16* Xr = Xrm + (st & 1) * (DL_SET2 / 2); LAS bf16* Pr = Prm + (st & 1) * (DL_SET2 / 2); LAS bf16* Pt = PT + (st & 1) * (DL_SET2 / 2);
        LAS bf16* Xw = Xrm + ((st + 1) & 1) * (DL_SET2 / 2); LAS bf16* Pw_ = Prm + ((st + 1) & 1) * (DL_SET2 / 2); LAS bf16* Ptw = PT + ((st + 1) & 1) * (DL_SET2 / 2);
#pragma unroll
        for (int q = 0; q < 2; ++q) {
            const int p = wave + 8 * q, mt = p >> 2, nt = p & 3;
            if (nt <= mt) {
                f32x4 Pn = (f32x4){0.f, 0.f, 0.f, 0.f};
#pragma unroll
                for (int ks = 0; ks < 2; ++ks) {
                    const bf16x8 b = *(const LAS bf16x8*)(Pt + (nt * 16 + fr) * 72 + ks * 32 + fq * 8);
                    if (st < 5) { const bf16x8 a = *(const LAS bf16x8*)(Pr + (mt * 16 + fr) * 72 + ks * 32 + fq * 8); Pn = MFMA16(a, b, Pn); }
                    if (st > 0) { const bf16x8 ax = *(const LAS bf16x8*)(Xr + (mt * 16 + fr) * 72 + ks * 32 + fq * 8); Xacc[q] = MFMA16(ax, b, Xacc[q]); }
                }
                const int jj = nt * 16 + fr;
#pragma unroll
                for (int j = 0; j < 4; ++j) { const int i = mt * 16 + fq * 4 + j;
                    Xw[i * 72 + jj] = (bf16)f2bf(Xacc[q][j]);
                    if (st < 5) { Pw_[i * 72 + jj] = (bf16)f2bf(Pn[j]); Ptw[jj * 72 + i] = (bf16)f2bf(Pn[j]); } }
            }
        }
        __syncthreads();
    }
    {
        bf16x8 ta[4][2];
#pragma unroll
        for (int mt = 0; mt < 4; ++mt)
#pragma unroll
            for (int ks = 0; ks < 2; ++ks) ta[mt][ks] = *(const LAS bf16x8*)(Xrm + (mt * 16 + fr) * 72 + ks * 32 + fq * 8);
        bf16x8 vb0, vb1, kb0, kb1;
#pragma unroll
        for (int i = 0; i < 8; ++i) { const int c0_ = (fq * 8 + i) * DL_RS + wave * 16 + fr, c1_ = c0_ + 32 * DL_RS;
            vb0[i] = (short)Vb[c0_]; vb1[i] = (short)Vb[c1_]; kb0[i] = (short)Kb[c0_]; kb1[i] = (short)Kb[c1_]; }
#pragma unroll
        for (int mt = 0; mt < 4; ++mt) {
            f32x4 u = (f32x4){0.f, 0.f, 0.f, 0.f}; u = MFMA16(ta[mt][0], vb0, u); u = MFMA16(ta[mt][1], vb1, u);
            *(f32x4*)(U0T + (wave * 16 + fr) * 64 + mt * 16 + fq * 4) = u;
            f32x4 wv = (f32x4){0.f, 0.f, 0.f, 0.f}; wv = MFMA16(kb0, ta[mt][0], wv); wv = MFMA16(kb1, ta[mt][1], wv);
            v2u o; o.x = pk2(wv[0], wv[1]); o.y = pk2(wv[2], wv[3]);
            *(v2u*)(WK + ((mt * 4 + (wave >> 1)) * 64 + lane) * 8 + (wave & 1) * 4) = o;
        }
    }
    {   v4u* dp = (v4u*)KDT;
#pragma unroll
        for (int q2 = 0; q2 < 2; ++q2) {
            const int j = tid + 512 * q2, f = j >> 6, lf = j & 63, dk_ = (f >> 1) * 16 + (lf & 15), cb = (f & 1) * 32 + (lf >> 4) * 4;
            bf16x8 w;
#pragma unroll
            for (int i = 0; i < 8; ++i) w[i] = (short)Kd[(cb + (i >> 2) * 16 + (i & 3)) * DL_RS + dk_];
            dp[j] = __builtin_bit_cast(v4u, w);
        }
    }
}

__device__ __forceinline__ bf16x8 pack_acc2(const f32x4 a, const f32x4 b) { v4u w; w.x = pk2(a[0], a[1]); w.y = pk2(a[2], a[3]); w.z = pk2(b[0], b[1]); w.w = pk2(b[2], b[3]); return __builtin_bit_cast(bf16x8, w); }
__device__ __forceinline__ void wait_flag(unsigned* f, unsigned seen) {
    unsigned sp = 0;
    while (seen == 0u) { __builtin_amdgcn_s_sleep(2); seen = __hip_atomic_load(f, __ATOMIC_RELAXED, __HIP_MEMORY_SCOPE_AGENT); if (++sp > (1u << 22)) break; }
    __builtin_amdgcn_fence(__ATOMIC_ACQUIRE, "agent");
}
__device__ __forceinline__ void dn_seq_chain(const Ctx& C0, int l, int s, int bl, int h, int half) {
    const Ctx C = relaunder(C0);
    const int lane = C.lane, wave = C.wave, fr = lane & 15, fq = lane >> 4;
    constexpr int SQ_BUF = 57344;
    const bool active = wave < 4;
    const int colw = half * 64 + (wave & 3) * 16;
    f32x4 Sacc[8];
#pragma unroll
    for (int mt = 0; mt < 8; ++mt) Sacc[mt] = (f32x4){0.f, 0.f, 0.f, 0.f};
    const float nA = -expf(INP(17)[l * 8 + h]), dtb = INP(18)[l * 8 + h];
    const int item0 = (bl * 8 + h) * 32; const size_t rlb = (size_t)bl * SEQ, rgb = (size_t)s * MS + rlb;
    const unsigned char* gWK = C.ws + WS_WK + (size_t)item0 * 16384; const unsigned char* gQD = C.ws + WS_QD + (size_t)item0 * 16384;
    const unsigned char* gKD = C.ws + WS_KDT + (size_t)item0 * 16384; const unsigned char* gQK = C.ws + WS_QK + (size_t)item0 * 8192;
    const float* gU0 = (const float*)(C.ws + WS_U0T) + (size_t)item0 * 8192 + colw * 64; const int lo_u0 = fr * 64 + fq * 4;
    bf16* gYC = (bf16*)(C.ws + WS_YC_OF(s)) + rlb * 1024 + h * 128 + colw; const int lo_row = fq * 4 * 1024 + fr;
    const float* gBA = (const float*)(C.ws + WS_BA) + (rgb + lane) * 16 + 8 + h;
    const int lo16 = lane * 16;
#define SQ_DMA(chunk_, buf_) do { _Pragma("unroll") for (int i_ = 0; i_ < 14; ++i_) { const int a_ = i_ >> 2; const int so_ = ((wave - 4) + 4 * (i_ & 3)) * 1024; \
        const unsigned char* gp = (a_ == 0 ? gWK : (a_ == 1 ? gQD : (a_ == 2 ? gKD : gQK))) + (size_t)(chunk_) * (a_ == 3 ? 8192 : 16384) + so_; \
        __builtin_amdgcn_global_load_lds((const unsigned*)(gp + lo16), (LAS unsigned*)(C.lds + (buf_) * SQ_BUF + a_ * 16384 + so_), 16, 0, 0); } } while (0)
    LAS float* cd = (LAS float*)(C.lds + 2 * SQ_BUF);
    __syncthreads();
    f32x4 u0r[4]; float ban = 0.f;
    unsigned ypend[8];
#pragma unroll
    for (int i = 0; i < 8; ++i) ypend[i] = 0u;
#pragma unroll
    for (int mt = 0; mt < 4; ++mt) u0r[mt] = (f32x4){0.f, 0.f, 0.f, 0.f};
    if (active) {
#pragma unroll
        for (int mt = 0; mt < 4; ++mt) u0r[mt] = *(const f32x4*)((gU0 + mt * 16) + lo_u0);
    } else {
        SQ_DMA(0, 0);
        if (wave == 4) { const float c0_ = __expf(wave_sum(nA * fsoftplus(gBA[0] + dtb))); if (lane == 0) cd[0] = c0_; ban = gBA[(size_t)64 * 16]; }
    }
    asm volatile("s_waitcnt vmcnt(0)" ::: "memory");
#pragma unroll 1
    for (int chunk = 0; chunk < 32; ++chunk) {
        if (!active) asm volatile("s_waitcnt vmcnt(0) lgkmcnt(0)" ::: "memory");
        else asm volatile("s_waitcnt lgkmcnt(0)" ::: "memory");
        __builtin_amdgcn_s_barrier();
        asm volatile("" ::: "memory");
        const bool more = chunk + 1 < 32;
        if (!active && more) {
            SQ_DMA(chunk + 1, (chunk + 1) & 1);
            if (wave == 4) { const float c1_ = __expf(wave_sum(nA * fsoftplus(ban + dtb))); if (lane == 0) cd[(chunk + 1) & 1] = c1_; if (chunk + 2 < 32) ban = gBA[(size_t)(chunk + 2) * 64 * 16]; }
        }
        if (active) {
            __builtin_amdgcn_s_setprio(3);
            const float cdec = cd[chunk & 1];
            const LAS unsigned char* B = C.lds + (chunk & 1) * SQ_BUF + lane * 16;
            bf16x8 Bs[4];
#pragma unroll
            for (int ks = 0; ks < 4; ++ks) Bs[ks] = pack_acc2(Sacc[2 * ks], Sacc[2 * ks + 1]);
            f32x4 u[4], o[4];
#pragma unroll
            for (int mt = 0; mt < 4; ++mt) {
                bf16x8 fa[4], fq_[4];
#pragma unroll
                for (int ks = 0; ks < 4; ++ks) { fa[ks] = *(const LAS bf16x8*)(B + (mt * 4 + ks) * 1024); fq_[ks] = *(const LAS bf16x8*)(B + 16384 + (mt * 4 + ks) * 1024); }
                f32x4 t = (f32x4){0.f, 0.f, 0.f, 0.f}; o[mt] = (f32x4){0.f, 0.f, 0.f, 0.f};
#pragma unroll
                for (int ks = 0; ks < 4; ++ks) { t = MFMA16(fa[ks], Bs[ks], t); o[mt] = MFMA16(fq_[ks], Bs[ks], o[mt]); }
                u[mt] = u0r[mt] - t;
            }
            if (more) {
#pragma unroll
                for (int mt = 0; mt < 4; ++mt) u0r[mt] = *(const f32x4*)((gU0 + (size_t)(chunk + 1) * 8192 + mt * 16) + lo_u0);
            }
            if (chunk > 0) {
#pragma unroll
                for (int i = 0; i < 16; ++i) (gYC + (size_t)((chunk - 1) * 64 + (i >> 2) * 16 + (i & 3)) * 1024)[lo_row] = (bf16)((i & 1) ? (ypend[i >> 1] >> 16) : (ypend[i >> 1] & 0xffffu));
            }
            bf16x8 Bu[2]; Bu[0] = pack_acc2(u[0], u[1]); Bu[1] = pack_acc2(u[2], u[3]);
            bf16x8 fk[8];
#pragma unroll
            for (int i = 0; i < 8; ++i) fk[i] = *(const LAS bf16x8*)(B + 49152 + i * 1024);
#pragma unroll
            for (int mt = 0; mt < 8; ++mt) Sacc[mt] = Sacc[mt] * cdec;
#pragma unroll
            for (int mt = 0; mt < 4; ++mt)
#pragma unroll
                for (int ks = 0; ks < 2; ++ks) o[mt] = MFMA16(fk[mt * 2 + ks], Bu[ks], o[mt]);
#pragma unroll
            for (int hh = 0; hh < 2; ++hh) {
#pragma unroll
                for (int i = 0; i < 8; ++i) fk[i] = *(const LAS bf16x8*)(B + 32768 + (hh * 8 + i) * 1024);
#pragma unroll
                for (int m4 = 0; m4 < 4; ++m4)
#pragma unroll
                    for (int ks = 0; ks < 2; ++ks) Sacc[hh * 4 + m4] = MFMA16(fk[m4 * 2 + ks], Bu[ks], Sacc[hh * 4 + m4]);
            }
#pragma unroll
            for (int mt = 0; mt < 4; ++mt) { ypend[mt * 2] = pk2(o[mt][0], o[mt][1]); ypend[mt * 2 + 1] = pk2(o[mt][2], o[mt][3]); }
            __builtin_amdgcn_s_setprio(0);
        }
    }
    if (active) {
#pragma unroll
        for (int i = 0; i < 16; ++i) (gYC + (size_t)(31 * 64 + (i >> 2) * 16 + (i & 3)) * 1024)[lo_row] = (bf16)((i & 1) ? (ypend[i >> 1] >> 16) : (ypend[i >> 1] & 0xffffu));
    }
#undef SQ_DMA
}
__device__ __forceinline__ void yc_finalize(const Ctx& C, int l, int s) {
    bf16* YC = (bf16*)(C.ws + WS_YC_OF(s)); const bf16* DZ = (const bf16*)(C.ws + WS_DZ);
    float gain[16];
#pragma unroll
    for (int q = 0; q < 4; ++q) { const f32x4 g = *(const f32x4*)(INP(19) + l * 1024 + C.lane * 16 + q * 4); gain[q * 4] = g.x; gain[q * 4 + 1] = g.y; gain[q * 4 + 2] = g.z; gain[q * 4 + 3] = g.w; }
    for (int m = C.gw; m < MS; m += C.NGW) {
        v4u* yp = (v4u*)(YC + (size_t)m * 1024 + C.lane * 16); const v4u* zp = (const v4u*)(DZ + (size_t)m * 1024 + C.lane * 16);
        const v4u a0 = yp[0], a1 = yp[1], z0 = zp[0], z1 = zp[1];
        float o[16], z[16]; unpack8(a0, o); unpack8(a1, o + 8); unpack8(z0, z); unpack8(z1, z + 8);
        float ss = 0.f;
#pragma unroll
        for (int e = 0; e < 16; ++e) ss += o[e] * o[e];
        ss += __shfl_xor(ss, 1); ss += __shfl_xor(ss, 2); ss += __shfl_xor(ss, 4);
        const float rn = rsqrtf(ss * (1.f / 128.f) + EPS);
#pragma unroll
        for (int e = 0; e < 16; ++e) o[e] = o[e] * rn * gain[e] * z[e];
        yp[0] = __builtin_bit_cast(v4u, pack8(o)); yp[1] = __builtin_bit_cast(v4u, pack8(o + 8));
    }
}

constexpr int PH_PER_LAYER = 8 + 6 * NSPLIT, N_PHASES = DEPTH * PH_PER_LAYER;
struct Args { const float* in[26]; float* out; unsigned char* ws; int ph_lo, ph_hi; };
constexpr int N_RG = BS * 16 * 2, N_DN = BS * 8 * 32, N_AT = BS * 12 * 16, N_ITEMS = N_RG + N_DN + N_AT;

__global__ void __launch_bounds__(NTHREADS, 2) fwd_kernel(Args args) {
    extern __shared__ __attribute__((aligned(16))) unsigned char lds_raw[];
    cg::grid_group grid = cg::this_grid();
    Ctx C;
    C.lds = (LAS unsigned char*)lds_raw; C.ldsg = lds_raw;
    C.tid = threadIdx.x; C.lane = C.tid & 63; C.wave = __builtin_amdgcn_readfirstlane(C.tid >> 6);
    C.G = gridDim.x; C.gw = blockIdx.x * NWAVES + C.wave; C.NGW = C.G * NWAVES;
    C.ws = args.ws; C.x = args.out;
    if (C.tid < 26) *(LAS unsigned long long*)(C.lds + PTAB_OFF + 8 * C.tid) = (unsigned long long)args.in[C.tid];
    __syncthreads();
    LAS int* slot = (LAS int*)(C.lds + LDS_BYTES - 64);
    int bx = blockIdx.x;

#pragma unroll 1
    for (int ph = args.ph_lo; ph < args.ph_hi; ++ph) {
        const int l = ph / PH_PER_LAYER, q = ph % PH_PER_LAYER;
#ifndef PROBE_MASK
#define PROBE_MASK 0
#endif
        int nrep = 1;
        if (PROBE_MASK) {
            const int sq_ = (q >= 4 && q < 4 + 6 * NSPLIT) ? (q - 4) % 6 : -1;
            if ((PROBE_MASK & 1) && (q == 0 || q == 3 || q == PH_PER_LAYER - 3)) nrep = 2;
            if ((PROBE_MASK & 2) && (q == 1 || q == PH_PER_LAYER - 2)) nrep = 2;
            if ((PROBE_MASK & 4) && sq_ == 0) nrep = 2;
            if ((PROBE_MASK & 8) && sq_ == 1) nrep = 2;
            if ((PROBE_MASK & 16) && sq_ == 2) nrep = 2;

            if ((PROBE_MASK & 32) && sq_ == 4) nrep = 2;
        }
#pragma unroll 1
        for (int rep = 0; rep < nrep; ++rep) {
        if (rep) grid.sync();
        { unsigned long long w_ = (unsigned long long)args.ws, x_ = (unsigned long long)args.out; int g_ = gridDim.x, b_ = blockIdx.x, t_ = threadIdx.x; asm volatile("" : "+s"(w_), "+s"(x_), "+s"(g_), "+s"(b_), "+v"(t_)); C.ws = (unsigned char*)(GAS unsigned char*)w_; C.x = (float*)(GAS float*)x_;
          C.G = g_; bx = b_; C.tid = t_; C.lane = t_ & 63; C.wave = __builtin_amdgcn_readfirstlane(t_ >> 6); C.gw = b_ * NWAVES + C.wave; C.NGW = g_ * NWAVES; }
        unsigned* ctl = (unsigned*)(C.ws + WS_CTL);
        if (q == 0 || q == PH_PER_LAYER - 3) {
            const int second = q != 0;
            if (l == 0 && q == 0) {
                if (bx == 0) { unsigned* cz = (unsigned*)(C.ws + WS_CTL); for (int i = C.tid; i < 16384; i += NTHREADS) cz[i] = 0u; }
                Ctx C2 = C; C2.x = const_cast<float*>(INP(0));
                prep_ffn(C2, INP(2), INP(3), INP(4), INP(1));
            } else {
                const size_t wo = (size_t)l * D * FF;
                prep_ffn(C, (second ? INP(23) : INP(2)) + wo, (second ? INP(24) : INP(3)) + wo, (second ? INP(25) : INP(4)) + wo, (second ? INP(22) : INP(1)) + l * D);
            }
        } else if (q == 1 || q == PH_PER_LAYER - 2) {
            pg8::Gemm g{(const pg8::bf16_t*)(C.ws + WS_XN), (const pg8::bf16_t*)(C.ws + WS_W1T), M, 2 * FF, D}; pg8::StaticOrder S; S.init(M, 2 * FF, C.G, bx);
            EpiFfnUp E{(bf16*)(C.ws + WS_H)};
            pg8::gemm_phase<EpiFfnUp, pg8::StaticOrder, true, true>(C.lds, g, S, E);
        } else if (q == 2 || q == PH_PER_LAYER - 1) {
            pg8::Gemm g{(const pg8::bf16_t*)(C.ws + WS_H), (const pg8::bf16_t*)(C.ws + WS_W2T), M, D, FF}; pg8::StaticOrder S; S.init(M, D, C.G, bx);
            EpiResid E{C.x, 0.5f, (l == 0 && q == 2) ? INP(0) : C.x};
            pg8::gemm_phase<EpiResid, pg8::StaticOrder, true, true>(C.lds, g, S, E);
        } else if (q == 3) {
            prep_mix(C, INP(6) + (size_t)l * D * IN_DIM, INP(20) + (size_t)l * 2816 * D, INP(21) + (size_t)l * D * D, INP(5) + l * D);
        } else if (q == 4 + 6 * NSPLIT) {
            pg8::Gemm g{(const pg8::bf16_t*)(C.ws + WS_XN), (const pg8::bf16_t*)(C.ws + WS_WOUT), M, D, D}; pg8::StaticOrder S; S.init(M, D, C.G, bx);
            EpiResid E{C.x, 1.0f, C.x};
            pg8::gemm_phase<EpiResid, pg8::StaticOrder, true, true>(C.lds, g, S, E);
        } else {
            const int s = (q - 4) / 6, sq = (q - 4) % 6;
            if (sq == 0) {
                pg8::Gemm g{(const pg8::bf16_t*)(C.ws + WS_XN) + (size_t)s * MS * D, (const pg8::bf16_t*)(C.ws + WS_WINT), MS, NPROJ, D}; pg8::StaticOrder S; S.init(MS, NPROJ, C.G, bx);
                EpiInProj E{C.ws};
                pg8::gemm_phase<EpiInProj, pg8::StaticOrder, true, true>(C.lds, g, S, E);
            } else if (sq == 1 || sq == 2) {
                constexpr int NCH = BS * 16;
                if (sq == 2 && bx < NCH) {
#ifndef NO_SEQ
                    dn_seq_chain(C, l, s, bx >> 4, (bx >> 1) & 7, bx & 1);
#endif
                } else {
                    unsigned* ctr = ctl + 64 * (1 + (l * NSPLIT + s) * 2 + (sq - 1) + 16 * rep);
                    const int n_items = sq == 1 ? N_RG + N_DN : (rep ? N_RG : N_RG + N_AT);
                    for (;;) {
                        __syncthreads();
                        if (C.tid == 0) *slot = (int)atomicAdd(ctr, 1u);
                        __syncthreads();
                        int id = *slot;
                        if (id >= n_items) break;
                        if (id < N_RG) {
#ifndef NO_RG
                            if (sq == 1) rg_item<0>(C, l, id >> 5, (id >> 1) & 15, id & 1); else rg_item<1>(C, l, id >> 5, (id >> 1) & 15, id & 1);
#endif
                            continue; }
                        id -= N_RG;
                        if (sq == 1) {
#ifndef NO_DNL
                            dn_local_item(C, l, s, (id >> 3) & 3, id & 7, id >> 5);
#endif
                            continue; }
#ifndef NO_ATT
                        attn_item(C, l, id / 192, (id % 192) >> 4, id & 15);
#endif
                    }
                }
            } else if (sq == 3) {
                if (!rep) attn_fix(C, bx, 0, C.G);
                if (!rep) yc_finalize(C, l, s);
            } else if (sq == 4) {
                const bf16* G = (const bf16*)(C.ws + WS_GATE); bf16* P = (bf16*)(C.ws + WS_DQ);
                if (C.G == 256) {
                    if (bx < 128) {
                        pg8::StaticOrder S; S.init(MS, D, 128, bx);
                        { pg8::Gemm g{(const pg8::bf16_t*)(C.ws + WS_YA), (const pg8::bf16_t*)(C.ws + WS_WBA), MS, D, 1024}; EpiPart E{G, P};
                          pg8::gemm_phase<EpiPart, pg8::StaticOrder, true, true>(C.lds, g, S, E); }
                        { pg8::Gemm g{(const pg8::bf16_t*)(C.ws + WS_YB), (const pg8::bf16_t*)(C.ws + WS_WBB), MS, D, 768}; EpiPart E{G + (size_t)MS * 1024, P + (size_t)MS * 1024};
                          pg8::gemm_phase<EpiPart, pg8::StaticOrder, true, true>(C.lds, g, S, E); }
                    } else {
                        pg8::StaticOrder S; S.init(MS, D, 128, bx - 128);
                        pg8::Gemm g{(const pg8::bf16_t*)(C.ws + WS_YC_OF(s)), (const pg8::bf16_t*)(C.ws + WS_WBC), MS, D, 1024}; EpiPart E{G + (size_t)2 * MS * 1024, P + (size_t)2 * MS * 1024};
                        pg8::gemm_phase<EpiPart, pg8::StaticOrder, true, true>(C.lds, g, S, E);
                    }
                } else {
                    pg8::StaticOrder S; S.init(MS, D, C.G, bx);
                    { pg8::Gemm g{(const pg8::bf16_t*)(C.ws + WS_YA), (const pg8::bf16_t*)(C.ws + WS_WBA), MS, D, 1024}; EpiPart E{G, P};
                      pg8::gemm_phase<EpiPart, pg8::StaticOrder, true, true>(C.lds, g, S, E); }
                    { pg8::Gemm g{(const pg8::bf16_t*)(C.ws + WS_YB), (const pg8::bf16_t*)(C.ws + WS_WBB), MS, D, 768}; EpiPart E{G + (size_t)MS * 1024, P + (size_t)MS * 1024};
                      pg8::gemm_phase<EpiPart, pg8::StaticOrder, true, true>(C.lds, g, S, E); }
                    { pg8::Gemm g{(const pg8::bf16_t*)(C.ws + WS_YC_OF(s)), (const pg8::bf16_t*)(C.ws + WS_WBC), MS, D, 1024}; EpiPart E{G + (size_t)2 * MS * 1024, P + (size_t)2 * MS * 1024};
                      pg8::gemm_phase<EpiPart, pg8::StaticOrder, true, true>(C.lds, g, S, E); }
                }
            } else {
                const v4u* P = (const v4u*)(C.ws + WS_DQ); v4u* Y = (v4u*)(C.ws + WS_YC_OF(s)); const size_t n16 = (size_t)MS * D / 8;
                for (size_t i = (size_t)bx * NTHREADS + C.tid; i < n16; i += (size_t)C.G * NTHREADS) {
                    const v4u a = P[i], b = P[i + n16], c = P[i + 2 * n16]; float x[8], y[8], z[8]; unpack8(a, x); unpack8(b, y); unpack8(c, z);
#pragma unroll
                    for (int e = 0; e < 8; ++e) x[e] = (x[e] + y[e]) + z[e];
                    Y[i] = __builtin_bit_cast(v4u, pack8(x));
                }
            }
        }
        }
        if (ph + 1 < args.ph_hi) grid.sync();
#ifdef PROBE_SYNC
        grid.sync(); grid.sync(); grid.sync();
#endif
    }
}

#ifndef MK_PER_PHASE
#define MK_PER_PHASE 0
#endif
extern "C" void kernel_launch(void* const* d_in, const int* in_sizes, int n_in, void* d_out, int out_size, void* d_ws, size_t ws_size, hipStream_t stream) {
    static int grid = 0;
    if (grid == 0) {
        if (n_in != 26 || out_size != M * D || ws_size < WS_END) { fprintf(stderr, "kernel_launch: unexpected shapes (n_in %d out %d ws %zu)\n", n_in, out_size, ws_size); grid = -1; return; }
        int dev = 0, cus = 0, per_cu = 0;
        hipGetDevice(&dev); hipDeviceGetAttribute(&cus, hipDeviceAttributeMultiprocessorCount, dev);
        if (hipFuncSetAttribute((const void*)fwd_kernel, hipFuncAttributeMaxDynamicSharedMemorySize, LDS_BYTES) != hipSuccess) { fprintf(stderr, "kernel_launch: hipFuncSetAttribute failed\n"); grid = -1; return; }
        if (hipOccupancyMaxActiveBlocksPerMultiprocessor(&per_cu, (const void*)fwd_kernel, NTHREADS, LDS_BYTES) != hipSuccess || per_cu < 1) { fprintf(stderr, "kernel_launch: occupancy query says %d\n", per_cu); per_cu = 1; }
        (void)hipGetLastError();
        grid = cus * (per_cu > 1 ? 1 : per_cu);
        fprintf(stderr, "kernel_launch: grid %d (cus %d per_cu %d)\n", grid, cus, per_cu);
    }
    if (grid < 0) return;
    Args a{};
    for (int i = 0; i < 26; ++i) a.in[i] = (const float*)d_in[i];
    a.out = (float*)d_out; a.ws = (unsigned char*)d_ws;
#if MK_PER_PHASE
    for (int ph = 0; ph < N_PHASES; ++ph) {
        a.ph_lo = ph; a.ph_hi = ph + 1; void* kargs[] = {&a};
        hipError_t e = hipLaunchCooperativeKernel((const void*)fwd_kernel, dim3(grid), dim3(NTHREADS), kargs, LDS_BYTES, stream);
        if (e != hipSuccess) { fprintf(stderr, "cooperative launch failed: %s\n", hipGetErrorString(e)); break; }
    }
#else
    a.ph_lo = 0; a.ph_hi = N_PHASES; void* kargs[] = {&a};
    hipError_t e = hipLaunchCooperativeKernel((const void*)fwd_kernel, dim3(grid), dim3(NTHREADS), kargs, LDS_BYTES, stream);
    if (e != hipSuccess) fprintf(stderr, "cooperative launch failed: %s\n", hipGetErrorString(e));
#endif
}
```

```cpp
#include <hip/hip_runtime.h>
#include <hip/hip_cooperative_groups.h>
#include <cstdio>
#include <cstdint>
namespace cg = cooperative_groups;
namespace pg8 {
#define PG8_LAS __attribute__((address_space(3)))
typedef unsigned short bf16_t;
typedef short bf16x8 __attribute__((ext_vector_type(8)));
typedef float f32x4 __attribute__((ext_vector_type(4)));
typedef unsigned u32x4 __attribute__((ext_vector_type(4)));
constexpr int BM = 256, BK = 64, HALF = 128, HTB = HALF * BK * 2  , STAGE_BYTES = 8 * HTB, NXCD = 8, WGM = 4;

__host__ __device__ __forceinline__ int lds_byte(int r, int c) { const int st = (r >> 4) * 2 + (c >> 5), rr = r & 15, cc = c & 31, ob = rr * 64 + cc * 2; return st * 1024 + (ob ^ (((ob >> 9) & 1) << 5)); }
__host__ __device__ __forceinline__ void stage_rc(int b, int& R, int& C) { const int st = b / 1024, sb = b % 1024, swz = sb ^ (((sb >> 9) & 1) << 5); R = (st >> 1) * 16 + swz / 64; C = (st & 1) * 32 + (swz % 64) / 2; }
__host__ __device__ __forceinline__ int perm32(int rho) { const int n = rho >> 4, i = rho & 15; return 8 * (i >> 2) + 4 * n + (i & 3); }

struct Unit { int pm, pn; };
struct Gemm { const bf16_t* A; const bf16_t* Bt; int M, N, K; };

struct StaticOrder {
    int nM, nN, nwg, G, c;
    __host__ __device__ void init(int M, int N, int G_, int c_) { nM = M / BM; nN = N / BM; nwg = nM * nN; G = G_; c = c_; }
    __host__ __device__ bool next(int i, Unit& u) const {
        const long L = (long)i * G + c; if (L >= nwg) return false;
        int wgid = (int)L; { const int q = nwg / NXCD, r = nwg % NXCD, xcd = wgid % NXCD, off = wgid / NXCD; wgid = (xcd < r ? xcd * (q + 1) : r * (q + 1) + (xcd - r) * q) + off; }
        const int nig = WGM * nN, gid = wgid / nig, fm = gid * WGM, gsz = (nM - fm) < WGM ? (nM - fm) : WGM;
        u.pm = fm + ((wgid % nig) % gsz); u.pn = (wgid % nig) / gsz; return true;
    }
    __device__ __forceinline__ void a_ready(const Unit&) const {}
    __device__ __forceinline__ void done(const Unit&) const {}
};

template <class Epi, class Sched, bool ALIGN_EPI = false, bool SP2 = false>
__device__ __forceinline__ void gemm_phase(PG8_LAS unsigned char* lds, const Gemm g, const Sched& S, const Epi& E) {
    int tid_ = threadIdx.x; asm volatile("" : "+v"(tid_));
    const int tid = tid_, wid = __builtin_amdgcn_readfirstlane(tid >> 6), lane = tid & 63, wr = wid >> 2, wc = wid & 3, fr = lane & 15, fq = lane >> 4;
    const int K = g.K, nt = K / BK;
    unsigned voffA[2], voffB[2];
#pragma unroll
    for (int i = 0; i < 2; ++i) { int R, C; stage_rc(tid * 16 + i * 8192, R, C); const int Rb = Epi::PERM ? ((R & ~31) + perm32(R & 31)) : R;
        voffA[i] = (unsigned)(R * K + C) * 2u; voffB[i] = (unsigned)(Rb * K + C) * 2u; }
    const size_t kstep = (size_t)(BK * 2);
    const size_t hstep = (size_t)HALF * K * 2;
    const size_t tstep = 2 * hstep;
    const unsigned ldsw = (unsigned)wid * 1024u;
    const int aoff = lds_byte(wr * 64 + fr, fq * 8), boff = lds_byte(wc * 32 + fr, fq * 8);
#define PG8_SA(b, h) (((b) * 2 + (h)) * HTB)
#define PG8_SB(b, h) ((4 + (b) * 2 + (h)) * HTB)
#define PG8_STAGE(bufoff, gbase, voff) do { _Pragma("unroll") for (int _i = 0; _i < 2; ++_i) \
        __builtin_amdgcn_global_load_lds((const unsigned*)((const char*)(gbase) + (voff)[_i]), (PG8_LAS unsigned*)(lds + (bufoff) + ldsw + _i * 8192), 16, 0, 0); } while (0)
#define PG8_LDA(dst, b, h) do { _Pragma("unroll") for (int m = 0; m < 4; ++m) _Pragma("unroll") for (int k = 0; k < 2; ++k) dst[m][k] = *(const PG8_LAS bf16x8*)(lds + PG8_SA(b, h) + aoff + m * 2048 + k * 1024); } while (0)
#define PG8_LDB(dst, b, h) do { _Pragma("unroll") for (int n = 0; n < 2; ++n) _Pragma("unroll") for (int k = 0; k < 2; ++k) dst[n][k] = *(const PG8_LAS bf16x8*)(lds + PG8_SB(b, h) + boff + n * 2048 + k * 1024); } while (0)
#define PG8_MMA(ai, bj, At, Bt) do { __builtin_amdgcn_s_setprio(1); _Pragma("unroll") for (int m = 0; m < 4; ++m) _Pragma("unroll") for (int n = 0; n < 2; ++n) _Pragma("unroll") for (int k = 0; k < 2; ++k) \
        acc[ai][bj][m][n] = __builtin_amdgcn_mfma_f32_16x16x32_bf16(Bt[n][k], At[m][k], acc[ai][bj][m][n], 0, 0, 0); __builtin_amdgcn_s_setprio(0); } while (0)
#define PG8_WAIT_V(n) asm volatile("s_waitcnt vmcnt(" #n ")" ::: "memory")
#define PG8_WAIT_L(n) asm volatile("s_waitcnt lgkmcnt(" #n ")" ::: "memory")
#define PG8_BAR __builtin_amdgcn_s_barrier()
#define PG8_SCHED __builtin_amdgcn_sched_barrier(0)
    Unit cur, nxt; int ui = 0;
    if (!S.next(0, cur)) return;
    f32x4 acc[2][2][4][2];
#pragma unroll
    for (int a = 0; a < 2; ++a)
#pragma unroll
        for (int b = 0; b < 2; ++b)
#pragma unroll
            for (int m = 0; m < 4; ++m)
#pragma unroll
                for (int n = 0; n < 2; ++n) acc[a][b][m][n] = (f32x4){0.f, 0.f, 0.f, 0.f};
    bf16x8 At[4][2], B0[2][2], B1[2][2];
    const char* cA = (const char*)g.A + (size_t)cur.pm * tstep; const char* cB = (const char*)g.Bt + (size_t)cur.pn * tstep;
    S.a_ready(cur);
    if constexpr (SP2) {
        PG8_STAGE(PG8_SB(0, 0), cB, voffB); PG8_STAGE(PG8_SB(0, 1), cB + hstep, voffB); PG8_STAGE(PG8_SA(0, 0), cA, voffA); PG8_STAGE(PG8_SA(0, 1), cA + hstep, voffA);
        if (wr == 1) PG8_BAR;
        PG8_WAIT_V(2); PG8_BAR;
        PG8_STAGE(PG8_SB(1, 0), cB + kstep, voffB); PG8_STAGE(PG8_SA(1, 0), cA + kstep, voffA); PG8_STAGE(PG8_SB(1, 1), cB + hstep + kstep, voffB);
        PG8_WAIT_V(6); PG8_BAR;
    } else {
        PG8_STAGE(PG8_SB(0, 0), cB, voffB); PG8_STAGE(PG8_SA(0, 0), cA, voffA); PG8_STAGE(PG8_SB(0, 1), cB + hstep, voffB); PG8_STAGE(PG8_SA(0, 1), cA + hstep, voffA);
        if (wr == 1) PG8_BAR;
        PG8_WAIT_V(4); PG8_BAR;
        PG8_STAGE(PG8_SB(1, 0), cB + kstep, voffB); PG8_STAGE(PG8_SA(1, 0), cA + kstep, voffA); PG8_STAGE(PG8_SB(1, 1), cB + hstep + kstep, voffB);
        PG8_WAIT_V(6); PG8_BAR;
    }
    for (;;) {
        const bool has_next = S.next(ui + 1, nxt);
        const char* nA = has_next ? (const char*)g.A + (size_t)nxt.pm * tstep : cA; const char* nB = has_next ? (const char*)g.Bt + (size_t)nxt.pn * tstep : cB;
        for (int t = 0; t < nt; t += 2) {
            const bool last = (t == nt - 2);
            const char* a1 = cA + (size_t)(t + 1) * kstep;
            const char* a2 = last ? nA : cA + (size_t)(t + 2) * kstep; const char* b2 = last ? nB : cB + (size_t)(t + 2) * kstep;
            const char* a3 = a2 + kstep; const char* b3 = b2 + kstep;
            if (last && has_next) S.a_ready(nxt);
            if constexpr (SP2) {
            PG8_LDB(B0, 0, 0); PG8_LDB(B1, 0, 1); PG8_SCHED; PG8_LDA(At, 0, 0); PG8_STAGE(PG8_SA(1, 1), a1 + hstep, voffA);
            PG8_WAIT_V(8); PG8_WAIT_L(0); PG8_BAR; PG8_MMA(0, 0, At, B0); PG8_MMA(0, 1, At, B1); PG8_BAR; PG8_SCHED;
            PG8_LDA(At, 0, 1); PG8_STAGE(PG8_SB(0, 0), b2, voffB); PG8_STAGE(PG8_SB(0, 1), b2 + hstep, voffB); PG8_STAGE(PG8_SA(0, 0), a2, voffA);
            PG8_WAIT_V(8); PG8_WAIT_L(0); PG8_BAR; PG8_MMA(1, 0, At, B0); PG8_MMA(1, 1, At, B1); PG8_BAR; PG8_SCHED;
            PG8_LDB(B0, 1, 0); PG8_LDB(B1, 1, 1); PG8_SCHED; PG8_LDA(At, 1, 0); PG8_STAGE(PG8_SA(0, 1), a2 + hstep, voffA);
            PG8_WAIT_V(8); PG8_WAIT_L(0); PG8_BAR; PG8_MMA(0, 0, At, B0); PG8_MMA(0, 1, At, B1); PG8_BAR; PG8_SCHED;
            PG8_LDA(At, 1, 1); PG8_STAGE(PG8_SB(1, 0), b3, voffB); PG8_STAGE(PG8_SB(1, 1), b3 + hstep, voffB); PG8_STAGE(PG8_SA(1, 0), a3, voffA);
            PG8_WAIT_V(8); PG8_WAIT_L(0); PG8_BAR; PG8_MMA(1, 0, At, B0); PG8_MMA(1, 1, At, B1); PG8_BAR; PG8_SCHED;
            } else {
            PG8_LDB(B0, 0, 0); PG8_SCHED; PG8_LDA(At, 0, 0); PG8_STAGE(PG8_SA(1, 1), a1 + hstep, voffA);
            PG8_WAIT_L(8); PG8_BAR; PG8_WAIT_L(0); PG8_MMA(0, 0, At, B0); PG8_BAR; PG8_SCHED;
            PG8_LDB(B1, 0, 1); PG8_STAGE(PG8_SB(0, 0), b2, voffB);
            PG8_BAR; PG8_WAIT_L(0); PG8_MMA(0, 1, At, B1); PG8_BAR;
            PG8_LDA(At, 0, 1); PG8_STAGE(PG8_SA(0, 0), a2, voffA);
            PG8_BAR; PG8_WAIT_L(0); PG8_MMA(1, 0, At, B0); PG8_BAR; PG8_SCHED;
            PG8_STAGE(PG8_SB(0, 1), b2 + hstep, voffB);
            PG8_WAIT_V(6); PG8_BAR; PG8_MMA(1, 1, At, B1); PG8_BAR;
            PG8_LDB(B0, 1, 0); PG8_SCHED; PG8_LDA(At, 1, 0); PG8_STAGE(PG8_SA(0, 1), a2 + hstep, voffA);
            PG8_WAIT_L(8); PG8_BAR; PG8_WAIT_L(0); PG8_MMA(0, 0, At, B0); PG8_BAR; PG8_SCHED;
            PG8_LDB(B1, 1, 1); PG8_STAGE(PG8_SB(1, 0), b3, voffB);
            PG8_BAR; PG8_WAIT_L(0); PG8_MMA(0, 1, At, B1); PG8_BAR;
            PG8_LDA(At, 1, 1); PG8_STAGE(PG8_SA(1, 0), a3, voffA);
            PG8_BAR; PG8_WAIT_L(0); PG8_MMA(1, 0, At, B0); PG8_BAR; PG8_SCHED;
            PG8_STAGE(PG8_SB(1, 1), b3 + hstep, voffB);
            PG8_WAIT_V(6); PG8_BAR; PG8_MMA(1, 1, At, B1); PG8_BAR;
            }
        }
        if constexpr (ALIGN_EPI) { if (wr == 0) PG8_BAR; }
        if constexpr (!Epi::AFTER_DRAIN) { E(acc, cur, wr, wc, fr, fq); S.done(cur); }
        if (!has_next) break;
#pragma unroll
        for (int a = 0; a < 2; ++a)
#pragma unroll
            for (int b = 0; b < 2; ++b)
#pragma unroll
                for (int m = 0; m < 4; ++m)
#pragma unroll
                    for (int n = 0; n < 2; ++n) acc[a][b][m][n] = (f32x4){0.f, 0.f, 0.f, 0.f};
        cur = nxt; cA = nA; cB = nB; ++ui;
        if constexpr (ALIGN_EPI) { if (wr == 1) PG8_BAR; }
    }
    PG8_WAIT_V(0);
    if constexpr (!ALIGN_EPI) { if (wr == 0) PG8_BAR; }
    PG8_BAR;
    if constexpr (Epi::AFTER_DRAIN) { E.fused(acc, cur, wr, wc, fr, fq, lds, wid, lane); S.done(cur); }
#undef PG8_SA
#undef PG8_SB
#undef PG8_STAGE
#undef PG8_LDA
#undef PG8_LDB
#undef PG8_MMA
#undef PG8_WAIT_V
#undef PG8_WAIT_L
#undef PG8_BAR
#undef PG8_SCHED
}
}

#define GAS __attribute__((address_space(1)))
#define LAS __attribute__((address_space(3)))
typedef unsigned short bf16;
typedef unsigned v4u __attribute__((ext_vector_type(4)));
typedef unsigned v2u __attribute__((ext_vector_type(2)));
typedef float f32x4 __attribute__((ext_vector_type(4)));
typedef float f32x2 __attribute__((ext_vector_type(2)));
typedef short bf16x8 __attribute__((ext_vector_type(8)));

constexpr int NWAVES = 8, NTHREADS = 512;
constexpr int BATCH = 8, SEQ = 2048, D = 1024, FF = 2816, M = BATCH * SEQ, DEPTH = 2;
constexpr int NSPLIT = 2, MS = M / NSPLIT, BS = BATCH / NSPLIT;
constexpr int IN_DIM = 11536, NPROJ = 11520;
constexpr int ATT_W = 768, NHEAD = 12, HD = 64;
constexpr int DNH = 8, DNK = 128;
constexpr float EPS = 1e-6f;

constexpr size_t MiB = 1u << 20;
constexpr size_t WS_CTL = 0;
constexpr size_t WS_WT = 1 * MiB;
constexpr size_t WS_W1T = WS_WT, WS_W2T = WS_WT + 11 * MiB;
constexpr size_t WS_WINT = WS_WT, WS_WBA = 24 * MiB, WS_WBB = 26 * MiB, WS_WBC = 28 * MiB, WS_WOUT = 30 * MiB;
constexpr size_t WS_XN = 32 * MiB;
constexpr size_t WS_BA = 64 * MiB;
constexpr size_t WS_LSE = 65 * MiB;
constexpr size_t WS_H = 66 * MiB;
constexpr size_t WS_RGX = 66 * MiB, WS_RGG = 82 * MiB, WS_AQ = 98 * MiB, WS_AK = 110 * MiB, WS_AV = 122 * MiB;
constexpr size_t WS_DQ = 134 * MiB, WS_DK = 150 * MiB, WS_DV = 166 * MiB, WS_DZ = 182 * MiB, WS_GATE = 198 * MiB;
constexpr size_t WS_U0T = 246 * MiB, WS_WK = 278 * MiB, WS_QD = 294 * MiB, WS_KDT = 310 * MiB, WS_QK = 326 * MiB;
constexpr size_t WS_YA = 334 * MiB, WS_SST = 350 * MiB, WS_END = 352 * MiB;
constexpr size_t WS_YB = WS_AQ, WS_YM = WS_DQ, WS_Y = WS_DV;
#define WS_YC_OF(s_) (WS_XN + (size_t)(s_) * MS * D * 2)
constexpr int LDS_BYTES = 147456;

typedef __bf16 hwbf16x2 __attribute__((ext_vector_type(2)));
__device__ __forceinline__ unsigned pk2(float lo, float hi) { const f32x2 v = {lo, hi}; return __builtin_bit_cast(unsigned, __builtin_convertvector(v, hwbf16x2)); }
__device__ __forceinline__ unsigned f2bf(float f) { return pk2(f, 0.f) & 0xffffu; }
__device__ __forceinline__ float bf2f(unsigned h) { return __builtin_bit_cast(float, h << 16); }
__device__ __forceinline__ float bflo(unsigned w) { return __builtin_bit_cast(float, w << 16); }
__device__ __forceinline__ float bfhi(unsigned w) { return __builtin_bit_cast(float, w & 0xffff0000u); }
__device__ __forceinline__ float fsigmoid(float v) { return __builtin_amdgcn_rcpf(1.f + __expf(-v)); }
__device__ __forceinline__ float fsilu(float v) { return v * fsigmoid(v); }
__device__ __forceinline__ float fgelu_tanh(float v) { const float u = 0.7978845608028654f * (v + 0.044715f * v * v * v); return v * fsigmoid(2.f * u); }
__device__ __forceinline__ float fsoftplus(float v) { return v > 20.f ? v : log1pf(__expf(v)); }
__device__ __forceinline__ float wave_sum(float v) {
#pragma unroll
    for (int o = 1; o < 64; o <<= 1) v += __shfl_xor(v, o);
    return v;
}
#define LDS_WAIT() asm volatile("s_waitcnt lgkmcnt(0)" ::: "memory")
template <int CTRL> __device__ __forceinline__ float dpp_mov(float v) { return __builtin_bit_cast(float, __builtin_amdgcn_update_dpp(0, __builtin_bit_cast(int, v), CTRL, 0xf, 0xf, false)); }
__device__ __forceinline__ float row16_sum(float v) { v += dpp_mov<0x128>(v); v += dpp_mov<0x124>(v); v += dpp_mov<0x122>(v); v += dpp_mov<0x121>(v); return v; }
__device__ __forceinline__ float row16_max(float v) { v = fmaxf(v, dpp_mov<0x128>(v)); v = fmaxf(v, dpp_mov<0x124>(v)); v = fmaxf(v, dpp_mov<0x122>(v)); v = fmaxf(v, dpp_mov<0x121>(v)); return v; }

using pg8::Unit;
typedef pg8::f32x4 (AccT)[2][2][4][2];
struct EpiFfnUp {
    static constexpr bool PERM = true, AFTER_DRAIN = false; bf16* H;
    __device__ __forceinline__ void operator()(const pg8::f32x4 (&acc)[2][2][4][2], const Unit& u, int wr, int wc, int fr, int fq) const {
        const int row0 = u.pm * 256 + wr * 64 + fr, col0 = u.pn * 128 + wc * 32 + 8 * fq;
#pragma unroll
        for (int ai = 0; ai < 2; ++ai)
#pragma unroll
            for (int m = 0; m < 4; ++m) {
                bf16* p = H + (size_t)(row0 + ai * 128 + m * 16) * FF + col0;
                float h[8];
#pragma unroll
                for (int n = 0; n < 2; ++n)
#pragma unroll
                    for (int e = 0; e < 4; ++e) h[n * 4 + e] = fsilu(acc[ai][0][m][n][e]) * acc[ai][1][m][n][e];
                v4u w; w.x = pk2(h[0], h[1]); w.y = pk2(h[2], h[3]); w.z = pk2(h[4], h[5]); w.w = pk2(h[6], h[7]);
                *(v4u*)p = w;
            }
    }
};
struct EpiResid {
    static constexpr bool PERM = false, AFTER_DRAIN = false; float* X; float scale; const float* Xsrc;
    __device__ __forceinline__ void operator()(const pg8::f32x4 (&acc)[2][2][4][2], const Unit& u, int wr, int wc, int fr, int fq) const {
        const int row0 = u.pm * 256 + wr * 64 + fr, col0 = u.pn * 256 + wc * 32 + 4 * fq; const ptrdiff_t sd = Xsrc - X;
#pragma unroll
        for (int ai = 0; ai < 2; ++ai)
#pragma unroll
            for (int m = 0; m < 4; ++m) {
                float* p = X + (size_t)(row0 + ai * 128 + m * 16) * D + col0;
#pragma unroll
                for (int bj = 0; bj < 2; ++bj)
#pragma unroll
                    for (int n = 0; n < 2; ++n) { f32x4* q = (f32x4*)(p + bj * 128 + n * 16); f32x4 v = *(const f32x4*)((const float*)q + sd); v = v + acc[ai][bj][m][n] * scale; *q = v; }
                asm volatile("" ::: "memory");
            }
    }
};
struct EpiInProj {
    static constexpr bool PERM = true, AFTER_DRAIN = false; unsigned char* ws;
    __device__ __forceinline__ void operator()(const pg8::f32x4 (&acc)[2][2][4][2], const Unit& u, int wr, int wc, int fr, int fq) const {
        const int pn = u.pn; size_t off; int t0, width, act = 0;
        if (pn < 4) { off = WS_RGX; t0 = 0; width = 1024; }
        else if (pn < 8) { off = WS_RGG; t0 = 4; width = 1024; act = 1; }
        else if (pn < 11) { off = WS_AQ; t0 = 8; width = 768; }
        else if (pn < 14) { off = WS_AK; t0 = 11; width = 768; }
        else if (pn < 17) { off = WS_AV; t0 = 14; width = 768; }
        else if (pn < 21) { off = WS_DQ; t0 = 17; width = 1024; }
        else if (pn < 25) { off = WS_DK; t0 = 21; width = 1024; }
        else if (pn < 29) { off = WS_DV; t0 = 25; width = 1024; }
        else if (pn < 33) { off = WS_DZ; t0 = 29; width = 1024; act = 2; }
        else { const int g = (pn - 33) >> 2; off = WS_GATE + (size_t)g * MS * 1024 * 2; t0 = 33 + 4 * g; width = 1024; act = 3; }
        bf16* base = (bf16*)(ws + off) + (size_t)(u.pm * 256 + wr * 64 + fr) * width + (pn - t0) * 256 + wc * 32 + 8 * fq;
        if (act == 0) store<false>(acc, base, width, 0); else store<true>(acc, base, width, act);
    }
    template <bool ACT> static __device__ __forceinline__ void store(const pg8::f32x4 (&acc)[2][2][4][2], bf16* base, int width, int act) {
        const bool is_gelu = act == 1, is_sig = act == 3;
#pragma unroll
        for (int ai = 0; ai < 2; ++ai)
#pragma unroll
            for (int m = 0; m < 4; ++m) {
                bf16* p = base + (size_t)(ai * 128 + m * 16) * width;
#pragma unroll
                for (int bj = 0; bj < 2; ++bj) {
                    float h[8];
#pragma unroll
                    for (int n = 0; n < 2; ++n)
#pragma unroll
                        for (int e = 0; e < 4; ++e) { float v = acc[ai][bj][m][n][e];
                            if (ACT) { const float zg = 1.5957691216057308f * (v + 0.044715f * v * v * v); const float z = is_gelu ? zg : v; const float sg = fsigmoid(z); v = is_sig ? sg : v * sg; }
                            h[n * 4 + e] = v; }
                    v4u w; w.x = pk2(h[0], h[1]); w.y = pk2(h[2], h[3]); w.z = pk2(h[4], h[5]); w.w = pk2(h[6], h[7]);
                    *(v4u*)(p + bj * 128) = w;
                }
            }
    }
};
template <int BR> struct EpiMerge {
    static constexpr bool PERM = true, AFTER_DRAIN = false; const bf16* G; float* Ym; bf16* Y;
    __device__ __forceinline__ void operator()(const pg8::f32x4 (&acc)[2][2][4][2], const Unit& u, int wr, int wc, int fr, int fq) const {
        const int row0 = u.pm * 256 + wr * 64 + fr, col0 = u.pn * 256 + wc * 32 + 8 * fq;
#pragma unroll
        for (int ai = 0; ai < 2; ++ai)
#pragma unroll
            for (int m = 0; m < 4; ++m) {
                const size_t ro = (size_t)(row0 + ai * 128 + m * 16) * D + col0;
#pragma unroll
                for (int bj = 0; bj < 2; ++bj) {
                    const v4u g = *(const v4u*)(G + ro + bj * 128);
                    f32x4 a0 = acc[ai][bj][m][0], a1 = acc[ai][bj][m][1];
                    a0[0] *= bflo(g.x); a0[1] *= bfhi(g.x); a0[2] *= bflo(g.y); a0[3] *= bfhi(g.y);
                    a1[0] *= bflo(g.z); a1[1] *= bfhi(g.z); a1[2] *= bflo(g.w); a1[3] *= bfhi(g.w);
                    f32x4* q = (f32x4*)(Ym + ro + bj * 128);
                    if (BR >= 1) { a0 = a0 + q[0]; a1 = a1 + q[1]; }
                    if (BR <= 1) { q[0] = a0; q[1] = a1; }
                    else { v4u w; w.x = pk2(a0[0], a0[1]); w.y = pk2(a0[2], a0[3]); w.z = pk2(a1[0], a1[1]); w.w = pk2(a1[2], a1[3]); *(v4u*)(Y + ro + bj * 128) = w; }
                }
                asm volatile("" ::: "memory");
            }
    }
};

struct EpiPart {
    static constexpr bool PERM = true, AFTER_DRAIN = false; const bf16* G; bf16* P;
    __device__ __forceinline__ void operator()(const pg8::f32x4 (&acc)[2][2][4][2], const Unit& u, int wr, int wc, int fr, int fq) const {
        const int row0 = u.pm * 256 + wr * 64 + fr, col0 = u.pn * 256 + wc * 32 + 8 * fq;
#pragma unroll
        for (int ai = 0; ai < 2; ++ai)
#pragma unroll
            for (int m = 0; m < 4; ++m) {
                const size_t ro = (size_t)(row0 + ai * 128 + m * 16) * D + col0;
#pragma unroll
                for (int bj = 0; bj < 2; ++bj) {
                    const v4u g = *(const v4u*)(G + ro + bj * 128);
                    const f32x4 a0 = acc[ai][bj][m][0], a1 = acc[ai][bj][m][1];
                    v4u w; w.x = pk2(a0[0] * bflo(g.x), a0[1] * bfhi(g.x)); w.y = pk2(a0[2] * bflo(g.y), a0[3] * bfhi(g.y));
                    w.z = pk2(a1[0] * bflo(g.z), a1[1] * bfhi(g.z)); w.w = pk2(a1[2] * bflo(g.w), a1[3] * bfhi(g.w));
                    *(v4u*)(P + ro + bj * 128) = w;
                }
            }
    }
};

struct Ctx {
    LAS unsigned char* lds; unsigned char* ldsg;
    int tid, lane, wave, G, gw, NGW;
    unsigned char* ws; float* x;
};
__device__ __forceinline__ Ctx relaunder(const Ctx& C0) {
    Ctx R = C0; int t_ = C0.tid; unsigned long long w_ = (unsigned long long)C0.ws; asm volatile("" : "+v"(t_), "+s"(w_));
    R.tid = t_; R.lane = t_ & 63; R.wave = __builtin_amdgcn_readfirstlane(t_ >> 6); R.ws = (unsigned char*)(GAS unsigned char*)w_; return R;
}
constexpr int PTAB_OFF = 147456 - 512;
#define INP(i) (ld_inp(C, (i)))
__device__ __forceinline__ const float* ld_inp(const Ctx& C, int i) {
    const unsigned long long v = *(const LAS unsigned long long*)(C.lds + PTAB_OFF + 8 * i);
    const unsigned lo = __builtin_amdgcn_readfirstlane((unsigned)v), hi = __builtin_amdgcn_readfirstlane((unsigned)(v >> 32));
    return (const float*)(GAS const float*)(((unsigned long long)hi << 32) | lo);
}
struct TrIt { const float* W; bf16* WT; int ldw, K, k0, n0, drow0; };
__device__ __forceinline__ void tr_load(const TrIt& t, float (&tv)[32], int lane) {
#pragma unroll
    for (int i = 0; i < 32; ++i) tv[i] = t.W[(size_t)(t.k0 + 2 * i + (lane >> 5)) * t.ldw + t.n0 + (lane & 31)];
}
__device__ __forceinline__ void tr_finish(const TrIt& t, const float (&tv)[32], LAS float* scr, int lane) {
#pragma unroll
    for (int i = 0; i < 32; ++i) scr[(2 * i + (lane >> 5)) * 33 + (lane & 31)] = tv[i];
    LDS_WAIT(); asm volatile("" ::: "memory");
    const int c = lane & 7;
#pragma unroll
    for (int j = 0; j < 4; ++j) { const int n = (lane >> 3) + 8 * j; const LAS float* s = scr + (8 * c) * 33 + n;
        v4u o; o.x = pk2(s[0 * 33], s[1 * 33]); o.y = pk2(s[2 * 33], s[3 * 33]); o.z = pk2(s[4 * 33], s[5 * 33]); o.w = pk2(s[6 * 33], s[7 * 33]);
        *(v4u*)(t.WT + (size_t)(t.drow0 + n) * t.K + t.k0 + 8 * c) = o; }
    LDS_WAIT(); asm volatile("" ::: "memory");
}
template <class Dec> __device__ __forceinline__ void run_transposes(const Ctx& C, const Dec& dec, int nitems, LAS float* scr) {
    int it = C.gw; if (it >= nitems) return;
    TrIt cur = dec(it); float tv[32]; tr_load(cur, tv, C.lane);
    for (;;) {
        const int nx = it + C.NGW; const bool has = nx < nitems;
        TrIt nxt = dec(has ? nx : it); float tn[32];
        tr_load(nxt, tn, C.lane);
        tr_finish(cur, tv, scr, C.lane);
        if (!has) break;
        cur = nxt; it = nx;
#pragma unroll
        for (int i = 0; i < 32; ++i) tv[i] = tn[i];
    }
}
__device__ __forceinline__ void norm_rows(const Ctx& C, const float* g, bf16* XN, const LAS float* Wl, float* BA) {
    f32x4 gv[4];
#pragma unroll
    for (int j = 0; j < 4; ++j) gv[j] = *((const f32x4*)g + C.lane + 64 * j);
    f32x4 vn[2][4];
#pragma unroll
    for (int rr = 0; rr < 2; ++rr) { const int m = min(C.gw + rr * C.NGW, M - 1); const f32x4* xr = (const f32x4*)(C.x + (size_t)m * D) + C.lane;
#pragma unroll
        for (int j = 0; j < 4; ++j) vn[rr][j] = xr[64 * j]; }
    for (int m0 = C.gw; m0 < M; m0 += 2 * C.NGW) {
        f32x4 v[2][4]; float s[2] = {0.f, 0.f};
#pragma unroll
        for (int rr = 0; rr < 2; ++rr)
#pragma unroll
            for (int j = 0; j < 4; ++j) v[rr][j] = vn[rr][j];
#pragma unroll
        for (int rr = 0; rr < 2; ++rr) { const int m = min(m0 + (2 + rr) * C.NGW, M - 1); const f32x4* xr = (const f32x4*)(C.x + (size_t)m * D) + C.lane;
#pragma unroll
            for (int j = 0; j < 4; ++j) vn[rr][j] = xr[64 * j]; }
#pragma unroll
        for (int rr = 0; rr < 2; ++rr) { const int m = m0 + rr * C.NGW; if (m >= M) break;
#pragma unroll
            for (int j = 0; j < 4; ++j) s[rr] += (v[rr][j].x * v[rr][j].x + v[rr][j].y * v[rr][j].y) + (v[rr][j].z * v[rr][j].z + v[rr][j].w * v[rr][j].w);
            const float rstd = rsqrtf(wave_sum(s[rr]) * (1.f / D) + EPS);
            unsigned long long* o8 = (unsigned long long*)(XN + (size_t)m * D) + C.lane;
#pragma unroll
            for (int j = 0; j < 4; ++j) { v[rr][j] = v[rr][j] * rstd * gv[j]; o8[64 * j] = (unsigned long long)pk2(v[rr][j].x, v[rr][j].y) | ((unsigned long long)pk2(v[rr][j].z, v[rr][j].w) << 32); }
            if (BA) {
                asm volatile("" ::: "memory");
                float mine = 0.f;
#pragma unroll
                for (int c = 0; c < 16; ++c) {
                    float a = 0.f;
#pragma unroll
                    for (int j = 0; j < 4; ++j) { const f32x4 w = *((const LAS f32x4*)(Wl + c * 1024) + C.lane + 64 * j); a += (v[rr][j].x * w.x + v[rr][j].y * w.y) + (v[rr][j].z * w.z + v[rr][j].w * w.w); }
                    const float t = wave_sum(a); if (C.lane == c) mine = t;
                }
                if (C.lane < 16) BA[(size_t)m * 16 + C.lane] = mine;
            }
        }
    }
}
__device__ __forceinline__ void ffn_transposes(const Ctx& C, const float* Wg, const float* Wu, const float* Wd) {
    LAS float* scr = (LAS float*)(C.lds + C.wave * 16384);
    bf16* W1T = (bf16*)(C.ws + WS_W1T); bf16* W2T = (bf16*)(C.ws + WS_W2T);
    constexpr int I1 = (D / 64) * (FF / 32), I2 = (FF / 64) * (D / 32);
    auto dec = [=](int it) -> TrIt {
        int r = it; TrIt t;
        if (r < 2 * I1) { const int up = r >= I1; if (up) r -= I1; const int kb = r / (FF / 32), nb = r % (FF / 32), n0 = 32 * nb;
            t.W = up ? Wu : Wg; t.WT = W1T; t.ldw = FF; t.K = D; t.k0 = 64 * kb; t.n0 = n0; t.drow0 = 256 * (n0 >> 7) + 128 * up + (n0 & 127); }
        else { r -= 2 * I1; const int kb = r / (D / 32), nb = r % (D / 32); t.W = Wd; t.WT = W2T; t.ldw = D; t.K = FF; t.k0 = 64 * kb; t.n0 = 32 * nb; t.drow0 = 32 * nb; }
        return t; };
    run_transposes(C, dec, 2 * I1 + I2, scr);
}
__device__ __forceinline__ void prep_ffn(const Ctx& C, const float* Wg, const float* Wu, const float* Wd, const float* gn, bool do_tr) {
    if (do_tr) ffn_transposes(C, Wg, Wu, Wd);
    norm_rows(C, gn, (bf16*)(C.ws + WS_XN), nullptr, nullptr);
}
__device__ __forceinline__ void prep_mix(const Ctx& C, const float* Win, const float* Wbr, const float* Wout, const float* gn) {
    LAS float* scr = (LAS float*)(C.lds + C.wave * 16384);
    constexpr int NB_IN = NPROJ / 32, I_IN = 16 * NB_IN, I_A = 16 * 32, I_B = 12 * 32, I_C = 16 * 32, I_O = 16 * 32;
    unsigned char* ws_ = C.ws;
    auto dec = [=](int it) -> TrIt {
        int r = it; TrIt t;
        if (r < I_IN) { const int kb = r / NB_IN, nb = r % NB_IN; const int drow = 32 * nb, n0 = drow < 8448 ? drow : drow + 16;
            t.W = Win; t.WT = (bf16*)(ws_ + WS_WINT); t.ldw = IN_DIM; t.K = D; t.k0 = 64 * kb; t.n0 = n0; t.drow0 = drow; return t; }
        r -= I_IN; t.ldw = D; t.k0 = 64 * (r / 32); t.n0 = 32 * (r % 32); t.drow0 = t.n0;
        if (r < I_A) { t.W = Wbr; t.WT = (bf16*)(ws_ + WS_WBA); t.K = 1024; return t; } r -= I_A; t.k0 = 64 * (r / 32); t.n0 = 32 * (r % 32); t.drow0 = t.n0;
        if (r < I_B) { t.W = Wbr + (size_t)1024 * D; t.WT = (bf16*)(ws_ + WS_WBB); t.K = 768; return t; } r -= I_B; t.k0 = 64 * (r / 32); t.n0 = 32 * (r % 32); t.drow0 = t.n0;
        if (r < I_C) { t.W = Wbr + (size_t)1792 * D; t.WT = (bf16*)(ws_ + WS_WBC); t.K = 1024; return t; } r -= I_C; t.k0 = 64 * (r / 32); t.n0 = 32 * (r % 32); t.drow0 = t.n0;
        t.W = Wout; t.WT = (bf16*)(ws_ + WS_WOUT); t.K = 1024; return t; };
    run_transposes(C, dec, I_IN + I_A + I_B + I_C + I_O, scr);
    __syncthreads();
    LAS float* Wl = (LAS float*)C.lds;
    for (int idx = C.tid; idx < 16 * 1024; idx += NTHREADS) { const int k = idx >> 4, c = idx & 15; Wl[c * 1024 + k] = Win[(size_t)k * IN_DIM + 8448 + c]; }
    __syncthreads();
    norm_rows(C, gn, (bf16*)(C.ws + WS_XN), Wl, (float*)(C.ws + WS_BA));
    __syncthreads();
}

template <int S> __device__ __forceinline__ float dpp_shr(float old, float v) {
    return __builtin_bit_cast(float, __builtin_amdgcn_update_dpp(__builtin_bit_cast(int, old), __builtin_bit_cast(int, v), 0x110 + S, 0xf, 0xf, false));
}
__device__ __forceinline__ float pm1(float y) {
    const float p = y * (1.f + y * (0.5f + y * (1.f / 6.f + y * (1.f / 24.f + y * (1.f / 120.f + y * (1.f / 720.f + y * (1.f / 5040.f)))))));
    if (__builtin_expect(__any(fabsf(y) >= 0.35f), 0)) return fabsf(y) < 0.35f ? p : __expf(y) - 1.f;
    return p;
}
__device__ __forceinline__ bf16x8 pack8(const float* v) {
    v4u w; w.x = pk2(v[0], v[1]); w.y = pk2(v[2], v[3]); w.z = pk2(v[4], v[5]); w.w = pk2(v[6], v[7]); return __builtin_bit_cast(bf16x8, w);
}
__device__ __forceinline__ void unpack8(v4u w, float* v) {
    v[0] = bflo(w.x); v[1] = bfhi(w.x); v[2] = bflo(w.y); v[3] = bfhi(w.y); v[4] = bflo(w.z); v[5] = bfhi(w.z); v[6] = bflo(w.w); v[7] = bfhi(w.w);
}
constexpr size_t WS_RGS = WS_LSE + 512 * 1024;
__device__ __forceinline__ float swz_row15(float v) { return __builtin_bit_cast(float, __builtin_amdgcn_ds_swizzle(__builtin_bit_cast(int, v), 0x1F0)); }
template <int PASS> __device__ __forceinline__ void rg_item(const Ctx& C0, int l, int bl, int n, int half) {
    const Ctx C = relaunder(C0);
    const int lane = C.lane, wave = C.wave, fr = lane & 15, fq = lane >> 4;
    const size_t base = (size_t)bl * SEQ * 1024 + n * 64;
    const bf16* X = (const bf16*)(C.ws + WS_RGX) + base; const bf16* Gt = (const bf16*)(C.ws + WS_RGG) + base; bf16* YA = (bf16*)(C.ws + WS_YA) + base;
    float* RGS = (float*)(C.ws + WS_RGS) + (size_t)(bl * 16 + n) * 16 * 128;
    LAS float* ctab = (LAS float*)C.lds;
    LAS float* Wl = (LAS float*)(C.lds + 2048);
    LAS bf16x8* Afr = (LAS bf16x8*)(C.lds + 2048 + 32768);
    __syncthreads();
    {   const int t = C.tid;
        if (t < 64) { const int ch = n * 64 + t;
#pragma unroll
            for (int k = 0; k < 4; ++k) ctab[k * 64 + t] = INP(7)[(size_t)l * 4096 + k * 1024 + ch];
            ctab[4 * 64 + t] = INP(8)[l * 1024 + ch]; ctab[5 * 64 + t] = INP(10)[l * 1024 + ch]; ctab[6 * 64 + t] = INP(12)[l * 1024 + ch];
            ctab[7 * 64 + t] = fsoftplus(-INP(13)[l * 1024 + ch]); }
        const float* wr_ = INP(9) + (size_t)l * 65536 + n * 4096; const float* wi_ = INP(11) + (size_t)l * 65536 + n * 4096;
        for (int i = t; i < 4096; i += NTHREADS) { Wl[i] = wr_[i]; Wl[4096 + i] = wi_[i]; }
    }
    __syncthreads();
#pragma unroll
    for (int q2 = 0; q2 < 2; ++q2) {
        const int combo = wave * 2 + q2, gate_ = combo >> 3, mt = (combo >> 1) & 3, ks = combo & 1;
        const int d = (mt >> 1) * 32 + (fr >> 2) * 8 + (mt & 1) * 4 + (fr & 3); float a[8];
#pragma unroll
        for (int i = 0; i < 8; ++i) { const int c = ks * 32 + fq * 8 + i; a[i] = Wl[gate_ * 4096 + c * 64 + d]; }
        Afr[combo * 64 + lane] = pack8(a);
    }
    __syncthreads();
    const int seg = half * 8 + wave;
    float cA[16], cB[16];
#pragma unroll
    for (int i = 0; i < 16; ++i) { cA[i] = 1.f; cB[i] = 0.f; }
    if (PASS == 1) {
        for (int s2 = 0; s2 < seg; ++s2) {
            const f32x4* sp = (const f32x4*)(RGS + (s2 * 4 + fq) * 32);
#pragma unroll
            for (int i = 0; i < 8; ++i) { const f32x4 v = sp[i]; cB[2 * i] = v.x * cB[2 * i] + v.y; cB[2 * i + 1] = v.z * cB[2 * i + 1] + v.w; }
        }
    }
    v4u raw[2][4];
    {   const int t = seg * 128 + fr;
#pragma unroll
        for (int s_ = 0; s_ < 2; ++s_)
#pragma unroll
            for (int k = 0; k < 4; ++k) { const int tt = t - 3 + k; raw[s_][k] = (v4u){0u, 0u, 0u, 0u}; if (tt >= 0) raw[s_][k] = *(const v4u*)(X + (size_t)tt * 1024 + s_ * 32 + fq * 8); }
    }
#pragma unroll 1
    for (int tile = 0; tile < 8; ++tile) {
        asm volatile("" ::: "memory");
        const int t = seg * 128 + tile * 16 + fr;
        v4u cur[2][4];
#pragma unroll
        for (int s_ = 0; s_ < 2; ++s_)
#pragma unroll
            for (int k = 0; k < 4; ++k) cur[s_][k] = raw[s_][k];
        if (tile + 1 < 8) {
#pragma unroll
            for (int s_ = 0; s_ < 2; ++s_)
#pragma unroll
                for (int k = 0; k < 4; ++k) raw[s_][k] = *(const v4u*)(X + (size_t)(t + 16 - 3 + k) * 1024 + s_ * 32 + fq * 8);
        }
        v4u graw[2];
        if (PASS == 1) {
#pragma unroll
            for (int s_ = 0; s_ < 2; ++s_) graw[s_] = *(const v4u*)(Gt + (size_t)t * 1024 + s_ * 32 + fq * 8);
        }
        float xa[16];
#pragma unroll
        for (int s_ = 0; s_ < 2; ++s_) {
            const int ch0 = s_ * 32 + fq * 8; float acc8[8];
            { const f32x4 c0 = *(const LAS f32x4*)(ctab + 4 * 64 + ch0), c1 = *(const LAS f32x4*)(ctab + 4 * 64 + ch0 + 4);
              acc8[0] = c0.x; acc8[1] = c0.y; acc8[2] = c0.z; acc8[3] = c0.w; acc8[4] = c1.x; acc8[5] = c1.y; acc8[6] = c1.z; acc8[7] = c1.w; }
#pragma unroll
            for (int k = 0; k < 4; ++k) {
                float xv[8]; unpack8(cur[s_][k], xv);
                const f32x4 w0 = *(const LAS f32x4*)(ctab + k * 64 + ch0), w1 = *(const LAS f32x4*)(ctab + k * 64 + ch0 + 4);
                acc8[0] += w0.x * xv[0]; acc8[1] += w0.y * xv[1]; acc8[2] += w0.z * xv[2]; acc8[3] += w0.w * xv[3];
                acc8[4] += w1.x * xv[4]; acc8[5] += w1.y * xv[5]; acc8[6] += w1.z * xv[6]; acc8[7] += w1.w * xv[7];
            }
#pragma unroll
            for (int e = 0; e < 8; ++e) xa[s_ * 8 + e] = acc8[e];
        }
        bf16x8 Bop[2]; Bop[0] = pack8(xa); Bop[1] = pack8(xa + 8);
        f32x4 ar[4], ai[4];
#pragma unroll
        for (int mt = 0; mt < 4; ++mt) {
            ar[mt] = (f32x4){0.f, 0.f, 0.f, 0.f}; ai[mt] = (f32x4){0.f, 0.f, 0.f, 0.f};
#pragma unroll
            for (int ks = 0; ks < 2; ++ks) { ar[mt] = __builtin_amdgcn_mfma_f32_16x16x32_bf16(Afr[(mt * 2 + ks) * 64 + lane], Bop[ks], ar[mt], 0, 0, 0); ai[mt] = __builtin_amdgcn_mfma_f32_16x16x32_bf16(Afr[(8 + mt * 2 + ks) * 64 + lane], Bop[ks], ai[mt], 0, 0, 0); }
        }
        float gate[16], hout[16];
        if (PASS == 1) { unpack8(graw[0], gate); unpack8(graw[1], gate + 8); }
        f32x4 cbr[4], cbi[4], csp[4];
#pragma unroll
        for (int mt = 0; mt < 4; ++mt) { const int ch0 = (mt >> 1) * 32 + fq * 8 + (mt & 1) * 4;
            cbr[mt] = *(const LAS f32x4*)(ctab + 5 * 64 + ch0); cbi[mt] = *(const LAS f32x4*)(ctab + 6 * 64 + ch0); csp[mt] = *(const LAS f32x4*)(ctab + 7 * 64 + ch0); }
#pragma unroll
        for (int mt = 0; mt < 4; ++mt)
#pragma unroll
            for (int j = 0; j < 4; ++j) {
                const int ci = (mt >> 1) * 8 + (mt & 1) * 4 + j;
                const float r = fsigmoid(ar[mt][j] + cbr[mt][j]), ig = fsigmoid(ai[mt][j] + cbi[mt][j]);
                const float la = -8.f * r * csp[mt][j];
                const float p1 = pm1(la);
                float A = 1.f + p1; float B = __builtin_amdgcn_sqrtf(fmaxf(-p1 * (p1 + 2.f), 0.f)) * (ig * xa[ci]);
                { float Ap = dpp_shr<1>(1.f, A), Bp = dpp_shr<1>(0.f, B); B = A * Bp + B; A = A * Ap; }
                { float Ap = dpp_shr<2>(1.f, A), Bp = dpp_shr<2>(0.f, B); B = A * Bp + B; A = A * Ap; }
                { float Ap = dpp_shr<4>(1.f, A), Bp = dpp_shr<4>(0.f, B); B = A * Bp + B; A = A * Ap; }
                { float Ap = dpp_shr<8>(1.f, A), Bp = dpp_shr<8>(0.f, B); B = A * Bp + B; A = A * Ap; }
                if (PASS == 0) {
                    const float A15 = swz_row15(A), B15 = swz_row15(B);
                    cB[ci] = A15 * cB[ci] + B15; cA[ci] = A15 * cA[ci];
                } else {
                    const float h = B + A * cB[ci];
                    cB[ci] = swz_row15(h);
                    hout[ci] = h * gate[ci];
                }
            }
        if (PASS == 1) {
#pragma unroll
            for (int s_ = 0; s_ < 2; ++s_) *(bf16x8*)(YA + (size_t)t * 1024 + s_ * 32 + fq * 8) = pack8(hout + s_ * 8);
        }
    }
    if (PASS == 0 && fr == 0) {
        f32x4* sp = (f32x4*)(RGS + (seg * 4 + fq) * 32);
#pragma unroll
        for (int i = 0; i < 8; ++i) sp[i] = (f32x4){cA[2 * i], cB[2 * i], cA[2 * i + 1], cB[2 * i + 1]};
    }
}

__device__ __forceinline__ void attn_item(const Ctx& C0, int l, int bl, int h, int blk) {
    const Ctx C = relaunder(C0);
    const int lane = C.lane, wave = C.wave, fr = lane & 15, fq = lane >> 4, tid = C.tid;
    const int g = h >> 2, dil = g == 0 ? 1 : (g == 1 ? 4 : 16);
    const int r = g == 0 ? 0 : (g == 1 ? (blk >> 2) : blk), nb = g == 0 ? blk : (g == 1 ? (blk & 3) : 0);
    const bf16* Q = (const bf16*)(C.ws + WS_AQ) + (size_t)bl * SEQ * ATT_W + h * 64;
    const bf16* K = (const bf16*)(C.ws + WS_AK) + (size_t)bl * SEQ * ATT_W + h * 64;
    const bf16* V = (const bf16*)(C.ws + WS_AV) + (size_t)bl * SEQ * ATT_W + h * 64;
    bf16* O = (bf16*)(C.ws + WS_YB) + (size_t)bl * SEQ * ATT_W + h * 64;
    float* LSE = (float*)(C.ws + WS_LSE) + (size_t)bl * SEQ * 12 + h;
    LAS bf16* VT = (LAS bf16*)C.lds;
    LAS bf16* Pw = (LAS bf16*)(C.lds + 64 * 264 * 2) + wave * (16 * 168);
    const float slope = exp2f(-8.f * (float)(h + 1) / 12.f) * (float)dil;
    __syncthreads();
    {
        const int key = tid & 255, half = tid >> 8; int lsub = (nb - 1) * 128 + key; if (lsub < 0) lsub = 0;
        const size_t t = (size_t)lsub * dil + r;
#pragma unroll
        for (int c = 0; c < 4; ++c) { const v4u raw = *(const v4u*)(V + t * ATT_W + half * 32 + c * 8); const int d0 = half * 32 + c * 8;
            VT[(d0 + 0) * 264 + key] = (bf16)(raw.x & 0xffff); VT[(d0 + 1) * 264 + key] = (bf16)(raw.x >> 16); VT[(d0 + 2) * 264 + key] = (bf16)(raw.y & 0xffff); VT[(d0 + 3) * 264 + key] = (bf16)(raw.y >> 16);
            VT[(d0 + 4) * 264 + key] = (bf16)(raw.z & 0xffff); VT[(d0 + 5) * 264 + key] = (bf16)(raw.z >> 16); VT[(d0 + 6) * 264 + key] = (bf16)(raw.w & 0xffff); VT[(d0 + 7) * 264 + key] = (bf16)(raw.w >> 16); }
        if (tid < 64) { for (int c = 256; c < 264; ++c) VT[tid * 264 + c] = 0; }
    }
    bf16x8 Aq[2];
    {   const size_t t = (size_t)(nb * 128 + wave * 16 + fr) * dil + r; float v[16]; float ss = 0.f;
#pragma unroll
        for (int ks = 0; ks < 2; ++ks) { const v4u raw = *(const v4u*)(Q + t * ATT_W + ks * 32 + fq * 8); unpack8(raw, v + ks * 8); }
#pragma unroll
        for (int i = 0; i < 16; ++i) ss += v[i] * v[i];
        ss += __shfl_xor(ss, 16); ss += __shfl_xor(ss, 32);
        const float rs = rsqrtf(ss * (1.f / 64.f) + EPS) * 0.125f;
#pragma unroll
        for (int ks = 0; ks < 2; ++ks) {
#pragma unroll
            for (int i = 0; i < 8; ++i) v[ks * 8 + i] *= rs * INP(14)[l * 768 + h * 64 + ks * 32 + fq * 8 + i];
            Aq[ks] = pack8(v + ks * 8); }
    }
    float gk[16];
#pragma unroll
    for (int ks = 0; ks < 2; ++ks)
#pragma unroll
        for (int i = 0; i < 8; ++i) gk[ks * 8 + i] = INP(15)[l * 768 + h * 64 + ks * 32 + fq * 8 + i];
    f32x4 sacc[9]; float mx[4];
#pragma unroll
    for (int j = 0; j < 4; ++j) mx[j] = -1e30f;
#pragma unroll
    for (int kk = 0; kk < 9; ++kk) {
        const int kt = wave + kk; int kj = kt * 16 + fr; int lsub = (nb - 1) * 128 + kj; if (lsub < 0) lsub = 0;
        const size_t t = (size_t)lsub * dil + r; float v[16]; float ss = 0.f;
#pragma unroll
        for (int ks = 0; ks < 2; ++ks) { const v4u raw = *(const v4u*)(K + t * ATT_W + ks * 32 + fq * 8); unpack8(raw, v + ks * 8); }
#pragma unroll
        for (int i = 0; i < 16; ++i) ss += v[i] * v[i];
        ss += __shfl_xor(ss, 16); ss += __shfl_xor(ss, 32);
        const float rs = rsqrtf(ss * (1.f / 64.f) + EPS);
#pragma unroll
        for (int i = 0; i < 16; ++i) v[i] *= rs * gk[i];
        f32x4 s = (f32x4){0.f, 0.f, 0.f, 0.f};
        s = __builtin_amdgcn_mfma_f32_16x16x32_bf16(Aq[0], pack8(v), s, 0, 0, 0);
        s = __builtin_amdgcn_mfma_f32_16x16x32_bf16(Aq[1], pack8(v + 8), s, 0, 0, 0);
#pragma unroll
        for (int j = 0; j < 4; ++j) {
            const int delta = wave * 16 + fq * 4 + j + 128 - kj;
            const bool valid = delta >= 0 && delta <= 128 && (nb > 0 || kj >= 128);
            s[j] = valid ? s[j] - slope * (float)delta : -1e30f;
            mx[j] = fmaxf(mx[j], s[j]);
        }
        sacc[kk] = s;
    }
    float den[4];
#pragma unroll
    for (int j = 0; j < 4; ++j) { mx[j] = row16_max(mx[j]); den[j] = 0.f; }
#pragma unroll
    for (int kk = 0; kk < 9; ++kk)
#pragma unroll
        for (int j = 0; j < 4; ++j) { const float p = __expf(sacc[kk][j] - mx[j]); den[j] += p; Pw[(fq * 4 + j) * 168 + kk * 16 + fr] = (bf16)f2bf(p); }
    if (fr < 8) {
#pragma unroll
        for (int j = 0; j < 4; ++j) { Pw[(fq * 4 + j) * 168 + 144 + fr] = 0; Pw[(fq * 4 + j) * 168 + 152 + fr] = 0; }
    }
#pragma unroll
    for (int j = 0; j < 4; ++j) { den[j] = row16_sum(den[j]); }
    __syncthreads();
    f32x4 oacc[4];
#pragma unroll
    for (int nt = 0; nt < 4; ++nt) oacc[nt] = (f32x4){0.f, 0.f, 0.f, 0.f};
#pragma unroll
    for (int ks = 0; ks < 5; ++ks) {
        const bf16x8 pa = *(const LAS bf16x8*)(Pw + fr * 168 + ks * 32 + fq * 8);
        int kb = wave * 16 + ks * 32 + fq * 8; if (kb > 256) kb = 256;
#pragma unroll
        for (int nt = 0; nt < 4; ++nt) { const bf16x8 vb = *(const LAS bf16x8*)(VT + (nt * 16 + fr) * 264 + kb); oacc[nt] = __builtin_amdgcn_mfma_f32_16x16x32_bf16(pa, vb, oacc[nt], 0, 0, 0); }
    }
#pragma unroll
    for (int j = 0; j < 4; ++j) {
        const size_t t = (size_t)(nb * 128 + wave * 16 + fq * 4 + j) * dil + r; const float inv = 1.f / den[j];
#pragma unroll
        for (int nt = 0; nt < 4; ++nt) O[t * ATT_W + nt * 16 + fr] = (bf16)f2bf(oacc[nt][j] * inv);
        if (fr == 0) LSE[t * 12] = mx[j] + __logf(den[j]);
    }
}
__device__ __forceinline__ void attn_fix(const Ctx& C, int bx, int first_block, int nblocks) {
    const bf16* dummy = nullptr; (void)dummy;
    bf16* Y = (bf16*)(C.ws + WS_YB); const float* LSE = (const float*)(C.ws + WS_LSE);
    const size_t total = (size_t)MS * 96, stride = (size_t)nblocks * NTHREADS;
    for (size_t i = (size_t)(bx - first_block) * NTHREADS + C.tid; i < total; i += stride) {
        const size_t row = i / 96; const int c = (int)(i % 96), head = c >> 3, g = head >> 2, j = head & 3;
        const float l0 = LSE[row * 12 + j], l1 = LSE[row * 12 + 4 + j], l2 = LSE[row * 12 + 8 + j];
        const float m = fmaxf(l0, fmaxf(l1, l2)); const float e0 = __expf(l0 - m), e1 = __expf(l1 - m), e2 = __expf(l2 - m);
        const float w = (g == 0 ? e0 : (g == 1 ? e1 : e2)) / (e0 + e1 + e2);
        v4u* p = (v4u*)(Y + row * ATT_W + c * 8); const v4u raw = *p; float v[8]; unpack8(raw, v);
#pragma unroll
        for (int e = 0; e < 8; ++e) v[e] *= w;
        *p = __builtin_bit_cast(v4u, pack8(v));
    }
}

constexpr int DL_KH = 0, DL_QH = 17408, DL_VB = 34816, DL_KB = 52480, DL_KD = 70144, DL_XRM = 87808, DL_PT = 97024, DL_PRM = 106240, DL_SET2 = 27648, DL_TAB = 115456 + 27648, DL_RS = 138;
__device__ __forceinline__ int permc(int c) { return (c & 32) + ((c & 15) >> 2) * 8 + ((c >> 4) & 1) * 4 + (c & 3); }
#define MFMA16(a, b, c) __builtin_amdgcn_mfma_f32_16x16x32_bf16(a, b, c, 0, 0, 0)
__device__ __forceinline__ void st_wt8(void* p, unsigned lo, unsigned hi) { __hip_atomic_store((GAS unsigned long long*)p, ((unsigned long long)hi << 32) | lo, __ATOMIC_RELAXED, __HIP_MEMORY_SCOPE_AGENT); }
__device__ __forceinline__ void st_wt2(void* p, unsigned v) { __hip_atomic_store((GAS unsigned short*)p, (unsigned short)v, __ATOMIC_RELAXED, __HIP_MEMORY_SCOPE_AGENT); }
__device__ __forceinline__ void dn_local_item(const Ctx& C0, int l, int s, int bl, int h, int chunk) {
    const Ctx C = relaunder(C0);
    const int lane = C.lane, wave = C.wave, fr = lane & 15, fq = lane >> 4, tid = C.tid;
    LAS bf16* Kh = (LAS bf16*)(C.lds + DL_KH); LAS bf16* Qh = (LAS bf16*)(C.lds + DL_QH); LAS bf16* Vb = (LAS bf16*)(C.lds + DL_VB); LAS bf16* Kb = (LAS bf16*)(C.lds + DL_KB);
    LAS bf16* Kd = (LAS bf16*)(C.lds + DL_KD); LAS bf16* Xrm = (LAS bf16*)(C.lds + DL_XRM); LAS bf16* PT = (LAS bf16*)(C.lds + DL_PT); LAS bf16* Prm = (LAS bf16*)(C.lds + DL_PRM);
    LAS float* gamT = (LAS float*)(C.lds + DL_TAB); LAS float* betT = gamT + 64;
    const int item = (bl * 8 + h) * 32 + chunk;
    const size_t rl0 = (size_t)bl * SEQ + chunk * 64;
    const size_t rg0 = (size_t)s * MS + rl0;
    float* U0T = (float*)(C.ws + WS_U0T) + (size_t)item * 8192; bf16* WK = (bf16*)(C.ws + WS_WK) + (size_t)item * 8192; bf16* QD = (bf16*)(C.ws + WS_QD) + (size_t)item * 8192;
    bf16* KDT = (bf16*)(C.ws + WS_KDT) + (size_t)item * 8192; bf16* QK = (bf16*)(C.ws + WS_QK) + (size_t)item * 4096;
    __syncthreads();
    float gam_last;
    {   const float* ba = (const float*)(C.ws + WS_BA) + (rg0 + lane) * 16;
        const float beta = fsigmoid(ba[h]);
        const float gl = -expf(INP(17)[l * 8 + h]) * fsoftplus(ba[8 + h] + INP(18)[l * 8 + h]);
        float gm = gl;
#pragma unroll
        for (int o = 1; o < 64; o <<= 1) { const float t = __shfl_up(gm, o); if (lane >= o) gm += t; }
        gamT[lane] = gm; betT[lane] = beta; gam_last = __shfl(gm, 63);
        LDS_WAIT();
    }
    {   const int rp = fq, cg = fr;
        const int tc0 = chunk * 64 + wave * 8 + rp * 2;
#pragma unroll
        for (int sec = 0; sec < 3; ++sec) {
            const bf16* src = (const bf16*)(C.ws + (sec == 0 ? WS_DQ : (sec == 1 ? WS_DK : WS_DV))) + h * 128 + cg * 8;
            v4u rawr[5];
#pragma unroll
            for (int k = 0; k < 5; ++k) { const int tt = tc0 - 3 + k; rawr[k] = (v4u){0u, 0u, 0u, 0u}; if (tt >= 0) rawr[k] = *(const v4u*)(src + ((size_t)bl * SEQ + tt) * 1024); }
            float w[4][8];
#pragma unroll
            for (int k = 0; k < 4; ++k) { const f32x4* wp = (const f32x4*)(INP(16) + (size_t)l * 12288 + k * 3072 + sec * 1024 + h * 128 + cg * 8); const f32x4 a = wp[0], b = wp[1];
                w[k][0] = a.x; w[k][1] = a.y; w[k][2] = a.z; w[k][3] = a.w; w[k][4] = b.x; w[k][5] = b.y; w[k][6] = b.z; w[k][7] = b.w; }
#pragma unroll
            for (int rr = 0; rr < 2; ++rr) {
                const int r = wave * 8 + rp * 2 + rr;
                float xw[4][8];
#pragma unroll
                for (int k = 0; k < 4; ++k) unpack8(rawr[rr + k], xw[k]);
                float val[8]; float ss = 0.f;
#pragma unroll
                for (int e = 0; e < 8; ++e) { const float a = w[0][e] * xw[0][e] + w[1][e] * xw[1][e] + w[2][e] * xw[2][e] + w[3][e] * xw[3][e]; val[e] = fsilu(a); ss += val[e] * val[e]; }
                ss = row16_sum(ss);
                const float rn = rsqrtf(ss + EPS), gm = gamT[r], bt = betT[r];
                if (sec == 0) {
                    float qh[8], qd[8]; const float eg = __expf(gm);
#pragma unroll
                    for (int e = 0; e < 8; ++e) { qh[e] = val[e] * rn * 0.08838834764831845f; qd[e] = qh[e] * eg; }
                    *(LAS bf16x8*)(Qh + r * 136 + cg * 8) = pack8(qh);
                    const int c0 = cg * 8, p0 = (c0 & ~31) + ((c0 & 15) >> 2) * 8 + ((c0 >> 4) & 1) * 4;
                    v2u a; a.x = pk2(qd[0], qd[1]); a.y = pk2(qd[2], qd[3]); v2u b; b.x = pk2(qd[4], qd[5]); b.y = pk2(qd[6], qd[7]);
                    { const int fi = ((r >> 4) * 4 + (p0 >> 5)) * 64 + ((p0 & 31) >> 3) * 16 + (r & 15);
                      *(v2u*)(QD + fi * 8 + (p0 & 7)) = a; *(v2u*)(QD + (fi + 16) * 8 + (p0 & 7)) = b; }
                } else if (sec == 1) {
                    float kh[8]; const float eb = bt * __expf(gm), ed = __expf(gam_last - gm);
#pragma unroll
                    for (int e = 0; e < 8; ++e) kh[e] = val[e] * rn;
                    *(LAS bf16x8*)(Kh + r * 136 + cg * 8) = pack8(kh);
                    LAS unsigned* pb = (LAS unsigned*)(Kb + r * DL_RS + cg * 8); LAS unsigned* pd = (LAS unsigned*)(Kd + r * DL_RS + cg * 8);
#pragma unroll
                    for (int e = 0; e < 4; ++e) { pb[e] = pk2(kh[2 * e] * eb, kh[2 * e + 1] * eb); pd[e] = pk2(kh[2 * e] * ed, kh[2 * e + 1] * ed); }
                } else {
                    LAS unsigned* pv = (LAS unsigned*)(Vb + r * DL_RS + cg * 8);
#pragma unroll
                    for (int e = 0; e < 4; ++e) pv[e] = pk2(val[2 * e] * bt, val[2 * e + 1] * bt);
                }
            }
        }
    }
    __syncthreads();
    f32x4 Xacc[2];
#pragma unroll
    for (int q = 0; q < 2; ++q) {
        const int p = wave + 8 * q, mt = p >> 2, nt = p & 3;
        f32x4 kk = (f32x4){0.f, 0.f, 0.f, 0.f}, qq = (f32x4){0.f, 0.f, 0.f, 0.f};
        if (nt <= mt) {
#pragma unroll
            for (int ks = 0; ks < 4; ++ks) {
                const bf16x8 a = *(const LAS bf16x8*)(Kh + (mt * 16 + fr) * 136 + ks * 32 + fq * 8), aq = *(const LAS bf16x8*)(Qh + (mt * 16 + fr) * 136 + ks * 32 + fq * 8);
                const bf16x8 b = *(const LAS bf16x8*)(Kh + (nt * 16 + fr) * 136 + ks * 32 + fq * 8);
                kk = MFMA16(a, b, kk); qq = MFMA16(aq, b, qq);
            }
        }
        const int jj = nt * 16 + fr; const float gj = gamT[jj];
        f32x4 xa;
#pragma unroll
        for (int j = 0; j < 4; ++j) {
            const int i = mt * 16 + fq * 4 + j; const float dec = (jj <= i) ? __expf(gamT[i] - gj) : 0.f;
            const float Aij = (jj < i) ? betT[i] * kk[j] * dec : 0.f; const float qk = (jj <= i) ? qq[j] * dec : 0.f;
            xa[j] = (i == jj ? 1.f : 0.f) - Aij;
            Xrm[i * 72 + jj] = (bf16)f2bf(xa[j]); Prm[i * 72 + jj] = (bf16)f2bf(Aij); PT[jj * 72 + i] = (bf16)f2bf(Aij);
            { const int pj = permc(jj); QK[(((i >> 4) * 2 + (pj >> 5)) * 64 + ((pj & 31) >> 3) * 16 + (i & 15)) * 8 + (pj & 7)] = (bf16)f2bf(qk); }
        }
        Xacc[q] = xa;
    }
    __syncthreads();
#pragma unroll
    for (int q = 0; q < 2; ++q) {
        const int p = wave + 8 * q, mt = p >> 2, nt = p & 3;
        if (nt > mt) {
            const int jj = nt * 16 + fr;
#pragma unroll
            for (int j = 0; j < 4; ++j) { const int i = mt * 16 + fq * 4 + j; (Xrm + DL_SET2 / 2)[i * 72 + jj] = 0; (Prm + DL_SET2 / 2)[i * 72 + jj] = 0; (PT + DL_SET2 / 2)[jj * 72 + i] = 0; }
        }
    }
#pragma unroll 1
    for (int st = 0; st < 6; ++st) {
        LAS bf16* Xr = Xrm + (st & 1) * (DL_SET2 / 2); LAS bf16* Pr = Prm + (st & 1) * (DL_SET2 / 2); LAS bf16* Pt = PT + (st & 1) * (DL_SET2 / 2);
        LAS bf16* Xw = Xrm + ((st + 1) & 1) * (DL_SET2 / 2); LAS bf16* Pw_ = Prm + ((st + 1) & 1) * (DL_SET2 / 2); LAS bf16* Ptw = PT + ((st + 1) & 1) * (DL_SET2 / 2);
#pragma unroll
        for (int q = 0; q < 2; ++q) {
            const int p = wave + 8 * q, mt = p >> 2, nt = p & 3;
            if (nt <= mt) {
                f32x4 Pn = (f32x4){0.f, 0.f, 0.f, 0.f};
#pragma unroll
                for (int ks = 0; ks < 2; ++ks) {
                    const bf16x8 b = *(const LAS bf16x8*)(Pt + (nt * 16 + fr) * 72 + ks * 32 + fq * 8);
                    if (st < 5) { const bf16x8 a = *(const LAS bf16x8*)(Pr + (mt * 16 + fr) * 72 + ks * 32 + fq * 8); Pn = MFMA16(a, b, Pn); }
                    if (st > 0) { const bf16x8 ax = *(const LAS bf16x8*)(Xr + (mt * 16 + fr) * 72 + ks * 32 + fq * 8); Xacc[q] = MFMA16(ax, b, Xacc[q]); }
                }
                const int jj = nt * 16 + fr;
#pragma unroll
                for (int j = 0; j < 4; ++j) { const int i = mt * 16 + fq * 4 + j;
                    Xw[i * 72 + jj] = (bf16)f2bf(Xacc[q][j]);
                    if (st < 5) { Pw_[i * 72 + jj] = (bf16)f2bf(Pn[j]); Ptw[jj * 72 + i] = (bf16)f2bf(Pn[j]); } }
            }
        }
        __syncthreads();
    }
    {
        bf16x8 ta[4][2];
#pragma unroll
        for (int mt = 0; mt < 4; ++mt)
#pragma unroll
            for (int ks = 0; ks < 2; ++ks) ta[mt][ks] = *(const LAS bf16x8*)(Xrm + (mt * 16 + fr) * 72 + ks * 32 + fq * 8);
        bf16x8 vb0, vb1, kb0, kb1;
#pragma unroll
        for (int i = 0; i < 8; ++i) { const int c0_ = (fq * 8 + i) * DL_RS + wave * 16 + fr, c1_ = c0_ + 32 * DL_RS;
            vb0[i] = (short)Vb[c0_]; vb1[i] = (short)Vb[c1_]; kb0[i] = (short)Kb[c0_]; kb1[i] = (short)Kb[c1_]; }
#pragma unroll
        for (int mt = 0; mt < 4; ++mt) {
            f32x4 u = (f32x4){0.f, 0.f, 0.f, 0.f}; u = MFMA16(ta[mt][0], vb0, u); u = MFMA16(ta[mt][1], vb1, u);
            *(f32x4*)(U0T + (wave * 16 + fr) * 64 + mt * 16 + fq * 4) = u;
            f32x4 wv = (f32x4){0.f, 0.f, 0.f, 0.f}; wv = MFMA16(kb0, ta[mt][0], wv); wv = MFMA16(kb1, ta[mt][1], wv);
            v2u o; o.x = pk2(wv[0], wv[1]); o.y = pk2(wv[2], wv[3]);
            *(v2u*)(WK + ((mt * 4 + (wave >> 1)) * 64 + lane) * 8 + (wave & 1) * 4) = o;
        }
    }
    {   v4u* dp = (v4u*)KDT;
#pragma unroll
        for (int q2 = 0; q2 < 2; ++q2) {
            const int j = tid + 512 * q2, f = j >> 6, lf = j & 63, dk_ = (f >> 1) * 16 + (lf & 15), cb = (f & 1) * 32 + (lf >> 4) * 4;
            bf16x8 w;
#pragma unroll
            for (int i = 0; i < 8; ++i) w[i] = (short)Kd[(cb + (i >> 2) * 16 + (i & 3)) * DL_RS + dk_];
            dp[j] = __builtin_bit_cast(v4u, w);
        }
    }
}

__device__ __forceinline__ bf16x8 pack_acc2(const f32x4 a, const f32x4 b) { v4u w; w.x = pk2(a[0], a[1]); w.y = pk2(a[2], a[3]); w.z = pk2(b[0], b[1]); w.w = pk2(b[2], b[3]); return __builtin_bit_cast(bf16x8, w); }
__device__ __forceinline__ void wait_flag(unsigned* f, unsigned seen) {
    unsigned sp = 0;
    while (seen == 0u) { __builtin_amdgcn_s_sleep(2); seen = __hip_atomic_load(f, __ATOMIC_RELAXED, __HIP_MEMORY_SCOPE_AGENT); if (++sp > (1u << 22)) break; }
    __builtin_amdgcn_fence(__ATOMIC_ACQUIRE, "agent");
}
__device__ __forceinline__ void dn_seq_chain(const Ctx& C0, int l, int s, int bl, int h, int half) {
    const Ctx C = relaunder(C0);
    const int lane = C.lane, wave = C.wave, fr = lane & 15, fq = lane >> 4;
    constexpr int SQ_BUF = 57344;
    const bool active = wave < 4;
    const int colw = half * 64 + (wave & 3) * 16;
    f32x4 Sacc[8];
#pragma unroll
    for (int mt = 0; mt < 8; ++mt) Sacc[mt] = (f32x4){0.f, 0.f, 0.f, 0.f};
    const float nA = -expf(INP(17)[l * 8 + h]), dtb = INP(18)[l * 8 + h];
    const int item0 = (bl * 8 + h) * 32; const size_t rlb = (size_t)bl * SEQ, rgb = (size_t)s * MS + rlb;
    const unsigned char* gWK = C.ws + WS_WK + (size_t)item0 * 16384; const unsigned char* gQD = C.ws + WS_QD + (size_t)item0 * 16384;
    const unsigned char* gKD = C.ws + WS_KDT + (size_t)item0 * 16384; const unsigned char* gQK = C.ws + WS_QK + (size_t)item0 * 8192;
    const float* gU0 = (const float*)(C.ws + WS_U0T) + (size_t)item0 * 8192 + colw * 64; const int lo_u0 = fr * 64 + fq * 4;
    bf16* gYC = (bf16*)(C.ws + WS_YC_OF(s)) + rlb * 1024 + h * 128 + colw; const int lo_row = fq * 4 * 1024 + fr;
    const float* gBA = (const float*)(C.ws + WS_BA) + (rgb + lane) * 16 + 8 + h;
    const int lo16 = lane * 16;
#define SQ_DMA(chunk_, buf_) do { _Pragma("unroll") for (int i_ = 0; i_ < 14; ++i_) { const int a_ = i_ >> 2; const int so_ = ((wave - 4) + 4 * (i_ & 3)) * 1024; \
        const unsigned char* gp = (a_ == 0 ? gWK : (a_ == 1 ? gQD : (a_ == 2 ? gKD : gQK))) + (size_t)(chunk_) * (a_ == 3 ? 8192 : 16384) + so_; \
        __builtin_amdgcn_global_load_lds((const unsigned*)(gp + lo16), (LAS unsigned*)(C.lds + (buf_) * SQ_BUF + a_ * 16384 + so_), 16, 0, 0); } } while (0)
    LAS float* cd = (LAS float*)(C.lds + 2 * SQ_BUF);
    __syncthreads();
    f32x4 u0r[4]; float ban = 0.f;
    unsigned ypend[8];
#pragma unroll
    for (int i = 0; i < 8; ++i) ypend[i] = 0u;
#pragma unroll
    for (int mt = 0; mt < 4; ++mt) u0r[mt] = (f32x4){0.f, 0.f, 0.f, 0.f};
    if (active) {
#pragma unroll
        for (int mt = 0; mt < 4; ++mt) u0r[mt] = *(const f32x4*)((gU0 + mt * 16) + lo_u0);
    } else {
        SQ_DMA(0, 0);
        if (wave == 4) { const float c0_ = __expf(wave_sum(nA * fsoftplus(gBA[0] + dtb))); if (lane == 0) cd[0] = c0_; ban = gBA[(size_t)64 * 16]; }
    }
    asm volatile("s_waitcnt vmcnt(0)" ::: "memory");
#pragma unroll 1
    for (int chunk = 0; chunk < 32; ++chunk) {
        if (!active) asm volatile("s_waitcnt vmcnt(0) lgkmcnt(0)" ::: "memory");
        else asm volatile("s_waitcnt lgkmcnt(0)" ::: "memory");
        __builtin_amdgcn_s_barrier();
        asm volatile("" ::: "memory");
        const bool more = chunk + 1 < 32;
        if (!active && more) {
            SQ_DMA(chunk + 1, (chunk + 1) & 1);
            if (wave == 4) { const float c1_ = __expf(wave_sum(nA * fsoftplus(ban + dtb))); if (lane == 0) cd[(chunk + 1) & 1] = c1_; if (chunk + 2 < 32) ban = gBA[(size_t)(chunk + 2) * 64 * 16]; }
        }
        if (active) {
            __builtin_amdgcn_s_setprio(3);
            const float cdec = cd[chunk & 1];
            const LAS unsigned char* B = C.lds + (chunk & 1) * SQ_BUF + lane * 16;
            bf16x8 Bs[4];
#pragma unroll
            for (int ks = 0; ks < 4; ++ks) Bs[ks] = pack_acc2(Sacc[2 * ks], Sacc[2 * ks + 1]);
            f32x4 u[4], o[4];
#pragma unroll
            for (int mt = 0; mt < 4; ++mt) {
                bf16x8 fa[4], fq_[4];
#pragma unroll
                for (int ks = 0; ks < 4; ++ks) { fa[ks] = *(const LAS bf16x8*)(B + (mt * 4 + ks) * 1024); fq_[ks] = *(const LAS bf16x8*)(B + 16384 + (mt * 4 + ks) * 1024); }
                f32x4 t = (f32x4){0.f, 0.f, 0.f, 0.f}; o[mt] = (f32x4){0.f, 0.f, 0.f, 0.f};
#pragma unroll
                for (int ks = 0; ks < 4; ++ks) { t = MFMA16(fa[ks], Bs[ks], t); o[mt] = MFMA16(fq_[ks], Bs[ks], o[mt]); }
                u[mt] = u0r[mt] - t;
            }
            if (more) {
#pragma unroll
                for (int mt = 0; mt < 4; ++mt) u0r[mt] = *(const f32x4*)((gU0 + (size_t)(chunk + 1) * 8192 + mt * 16) + lo_u0);
            }
            if (chunk > 0) {
#pragma unroll
                for (int i = 0; i < 16; ++i) (gYC + (size_t)((chunk - 1) * 64 + (i >> 2) * 16 + (i & 3)) * 1024)[lo_row] = (bf16)((i & 1) ? (ypend[i >> 1] >> 16) : (ypend[i >> 1] & 0xffffu));
            }
            bf16x8 Bu[2]; Bu[0] = pack_acc2(u[0], u[1]); Bu[1] = pack_acc2(u[2], u[3]);
            bf16x8 fk[8];
#pragma unroll
            for (int i = 0; i < 8; ++i) fk[i] = *(const LAS bf16x8*)(B + 49152 + i * 1024);
#pragma unroll
            for (int mt = 0; mt < 8; ++mt) Sacc[mt] = Sacc[mt] * cdec;
#pragma unroll
            for (int mt = 0; mt < 4; ++mt)
#pragma unroll
                for (int ks = 0; ks < 2; ++ks) o[mt] = MFMA16(fk[mt * 2 + ks], Bu[ks], o[mt]);
#pragma unroll
            for (int hh = 0; hh < 2; ++hh) {
#pragma unroll
                for (int i = 0; i < 8; ++i) fk[i] = *(const LAS bf16x8*)(B + 32768 + (hh * 8 + i) * 1024);
#pragma unroll
                for (int m4 = 0; m4 < 4; ++m4)
#pragma unroll
                    for (int ks = 0; ks < 2; ++ks) Sacc[hh * 4 + m4] = MFMA16(fk[m4 * 2 + ks], Bu[ks], Sacc[hh * 4 + m4]);
            }
#pragma unroll
            for (int mt = 0; mt < 4; ++mt) { ypend[mt * 2] = pk2(o[mt][0], o[mt][1]); ypend[mt * 2 + 1] = pk2(o[mt][2], o[mt][3]); }
            __builtin_amdgcn_s_setprio(0);
        }
    }
    if (active) {
#pragma unroll
        for (int i = 0; i < 16; ++i) (gYC + (size_t)(31 * 64 + (i >> 2) * 16 + (i & 3)) * 1024)[lo_row] = (bf16)((i & 1) ? (ypend[i >> 1] >> 16) : (ypend[i >> 1] & 0xffffu));
    }
#undef SQ_DMA
}
__device__ __forceinline__ void yc_finalize(const Ctx& C, int l, int s) {
    bf16* YC = (bf16*)(C.ws + WS_YC_OF(s)); const bf16* DZ = (const bf16*)(C.ws + WS_DZ);
    float gain[16];
#pragma unroll
    for (int q = 0; q < 4; ++q) { const f32x4 g = *(const f32x4*)(INP(19) + l * 1024 + C.lane * 16 + q * 4); gain[q * 4] = g.x; gain[q * 4 + 1] = g.y; gain[q * 4 + 2] = g.z; gain[q * 4 + 3] = g.w; }
    for (int m = C.gw; m < MS; m += C.NGW) {
        v4u* yp = (v4u*)(YC + (size_t)m * 1024 + C.lane * 16); const v4u* zp = (const v4u*)(DZ + (size_t)m * 1024 + C.lane * 16);
        const v4u a0 = yp[0], a1 = yp[1], z0 = zp[0], z1 = zp[1];
        float o[16], z[16]; unpack8(a0, o); unpack8(a1, o + 8); unpack8(z0, z); unpack8(z1, z + 8);
        float ss = 0.f;
#pragma unroll
        for (int e = 0; e < 16; ++e) ss += o[e] * o[e];
        ss += __shfl_xor(ss, 1); ss += __shfl_xor(ss, 2); ss += __shfl_xor(ss, 4);
        const float rn = rsqrtf(ss * (1.f / 128.f) + EPS);
#pragma unroll
        for (int e = 0; e < 16; ++e) o[e] = o[e] * rn * gain[e] * z[e];
        yp[0] = __builtin_bit_cast(v4u, pack8(o)); yp[1] = __builtin_bit_cast(v4u, pack8(o + 8));
    }
}

constexpr int PH_PER_LAYER = 8 + 6 * NSPLIT, N_PHASES = DEPTH * PH_PER_LAYER;
struct Args { const float* in[26]; float* out; unsigned char* ws; int ph_lo, ph_hi; };
constexpr int N_RG = BS * 16 * 2, N_DN = BS * 8 * 32, N_AT = BS * 12 * 16, N_ITEMS = N_RG + N_DN + N_AT;

__global__ void __launch_bounds__(NTHREADS, 2) fwd_kernel(Args args) {
    extern __shared__ __attribute__((aligned(16))) unsigned char lds_raw[];
    cg::grid_group grid = cg::this_grid();
    Ctx C;
    C.lds = (LAS unsigned char*)lds_raw; C.ldsg = lds_raw;
    C.tid = threadIdx.x; C.lane = C.tid & 63; C.wave = __builtin_amdgcn_readfirstlane(C.tid >> 6);
    C.G = gridDim.x; C.gw = blockIdx.x * NWAVES + C.wave; C.NGW = C.G * NWAVES;
    C.ws = args.ws; C.x = args.out;
    if (C.tid < 26) *(LAS unsigned long long*)(C.lds + PTAB_OFF + 8 * C.tid) = (unsigned long long)args.in[C.tid];
    __syncthreads();
    LAS int* slot = (LAS int*)(C.lds + LDS_BYTES - 64);
    int bx = blockIdx.x;

#pragma unroll 1
    for (int ph = args.ph_lo; ph < args.ph_hi; ++ph) {
        const int l = ph / PH_PER_LAYER, q = ph % PH_PER_LAYER;
#ifndef PROBE_MASK
#define PROBE_MASK 0
#endif
        int nrep = 1;
        if (PROBE_MASK) {
            const int sq_ = (q >= 4 && q < 4 + 6 * NSPLIT) ? (q - 4) % 6 : -1;
            if ((PROBE_MASK & 1) && (q == 0 || q == 3 || q == PH_PER_LAYER - 3)) nrep = 2;
            if ((PROBE_MASK & 2) && (q == 1 || q == PH_PER_LAYER - 2)) nrep = 2;
            if ((PROBE_MASK & 4) && sq_ == 0) nrep = 2;
            if ((PROBE_MASK & 8) && sq_ == 1) nrep = 2;
            if ((PROBE_MASK & 16) && sq_ == 2) nrep = 2;

            if ((PROBE_MASK & 32) && sq_ == 4) nrep = 2;
        }
#pragma unroll 1
        for (int rep = 0; rep < nrep; ++rep) {
        if (rep) grid.sync();
        { unsigned long long w_ = (unsigned long long)args.ws, x_ = (unsigned long long)args.out; int g_ = gridDim.x, b_ = blockIdx.x, t_ = threadIdx.x; asm volatile("" : "+s"(w_), "+s"(x_), "+s"(g_), "+s"(b_), "+v"(t_)); C.ws = (unsigned char*)(GAS unsigned char*)w_; C.x = (float*)(GAS float*)x_;
          C.G = g_; bx = b_; C.tid = t_; C.lane = t_ & 63; C.wave = __builtin_amdgcn_readfirstlane(t_ >> 6); C.gw = b_ * NWAVES + C.wave; C.NGW = g_ * NWAVES; }
        unsigned* ctl = (unsigned*)(C.ws + WS_CTL);
        if (q == 0 || q == PH_PER_LAYER - 3) {
            const int second = q != 0;
            if (l == 0 && q == 0) {
                if (bx == 0) { unsigned* cz = (unsigned*)(C.ws + WS_CTL); for (int i = C.tid; i < 16384; i += NTHREADS) cz[i] = 0u; }
                Ctx C2 = C; C2.x = const_cast<float*>(INP(0));
                prep_ffn(C2, INP(2), INP(3), INP(4), INP(1), true);
            } else {
                const size_t wo = (size_t)l * D * FF;
                prep_ffn(C, (second ? INP(23) : INP(2)) + wo, (second ? INP(24) : INP(3)) + wo, (second ? INP(25) : INP(4)) + wo, (second ? INP(22) : INP(1)) + l * D, !(second && C.G == 256));
            }
        } else if (q == 1 || q == PH_PER_LAYER - 2) {
            pg8::Gemm g{(const pg8::bf16_t*)(C.ws + WS_XN), (const pg8::bf16_t*)(C.ws + WS_W1T), M, 2 * FF, D}; pg8::StaticOrder S; S.init(M, 2 * FF, C.G, bx);
            EpiFfnUp E{(bf16*)(C.ws + WS_H)};
            pg8::gemm_phase<EpiFfnUp, pg8::StaticOrder, true, true>(C.lds, g, S, E);
        } else if (q == 2 || q == PH_PER_LAYER - 1) {
            pg8::Gemm g{(const pg8::bf16_t*)(C.ws + WS_H), (const pg8::bf16_t*)(C.ws + WS_W2T), M, D, FF}; pg8::StaticOrder S; S.init(M, D, C.G, bx);
            EpiResid E{C.x, 0.5f, (l == 0 && q == 2) ? INP(0) : C.x};
            pg8::gemm_phase<EpiResid, pg8::StaticOrder, true, true>(C.lds, g, S, E);
        } else if (q == 3) {
            prep_mix(C, INP(6) + (size_t)l * D * IN_DIM, INP(20) + (size_t)l * 2816 * D, INP(21) + (size_t)l * D * D, INP(5) + l * D);
        } else if (q == 4 + 6 * NSPLIT) {
            pg8::Gemm g{(const pg8::bf16_t*)(C.ws + WS_XN), (const pg8::bf16_t*)(C.ws + WS_WOUT), M, D, D}; pg8::StaticOrder S; S.init(M, D, C.G, bx);
            EpiResid E{C.x, 1.0f, C.x};
            pg8::gemm_phase<EpiResid, pg8::StaticOrder, true, true>(C.lds, g, S, E);
        } else {
            const int s = (q - 4) / 6, sq = (q - 4) % 6;
            if (sq == 0) {
                pg8::Gemm g{(const pg8::bf16_t*)(C.ws + WS_XN) + (size_t)s * MS * D, (const pg8::bf16_t*)(C.ws + WS_WINT), MS, NPROJ, D}; pg8::StaticOrder S; S.init(MS, NPROJ, C.G, bx);
                EpiInProj E{C.ws};
                pg8::gemm_phase<EpiInProj, pg8::StaticOrder, true, true>(C.lds, g, S, E);
            } else if (sq == 1 || sq == 2) {
                constexpr int NCH = BS * 16;
                if (sq == 2 && bx < NCH) {
#ifndef NO_SEQ
                    dn_seq_chain(C, l, s, bx >> 4, (bx >> 1) & 7, bx & 1);
#endif
                } else {
                    unsigned* ctr = ctl + 64 * (1 + (l * NSPLIT + s) * 2 + (sq - 1) + 16 * rep);
                    const int n_items = sq == 1 ? N_RG + N_DN : (rep ? N_RG : N_RG + N_AT);
                    for (;;) {
                        __syncthreads();
                        if (C.tid == 0) *slot = (int)atomicAdd(ctr, 1u);
                        __syncthreads();
                        int id = *slot;
                        if (id >= n_items) break;
                        if (id < N_RG) {
#ifndef NO_RG
                            if (sq == 1) rg_item<0>(C, l, id >> 5, (id >> 1) & 15, id & 1); else rg_item<1>(C, l, id >> 5, (id >> 1) & 15, id & 1);
#endif
                            continue; }
                        id -= N_RG;
                        if (sq == 1) {
#ifndef NO_DNL
                            dn_local_item(C, l, s, (id >> 3) & 3, id & 7, id >> 5);
#endif
                            continue; }
#ifndef NO_ATT
                        attn_item(C, l, id / 192, (id % 192) >> 4, id & 15);
#endif
                    }
                }
            } else if (sq == 3) {
                if (!rep) attn_fix(C, bx, 0, C.G);
                if (!rep) yc_finalize(C, l, s);
            } else if (sq == 4) {
                const bf16* G = (const bf16*)(C.ws + WS_GATE); bf16* P = (bf16*)(C.ws + WS_DQ);
                if (C.G == 256) {
                    if (bx < 128) {
                        pg8::StaticOrder S; S.init(MS, D, 128, bx);
                        { pg8::Gemm g{(const pg8::bf16_t*)(C.ws + WS_YA), (const pg8::bf16_t*)(C.ws + WS_WBA), MS, D, 1024}; EpiPart E{G, P};
                          pg8::gemm_phase<EpiPart, pg8::StaticOrder, true, true>(C.lds, g, S, E); }
                        { pg8::Gemm g{(const pg8::bf16_t*)(C.ws + WS_YB), (const pg8::bf16_t*)(C.ws + WS_WBB), MS, D, 768}; EpiPart E{G + (size_t)MS * 1024, P + (size_t)MS * 1024};
                          pg8::gemm_phase<EpiPart, pg8::StaticOrder, true, true>(C.lds, g, S, E); }
                    } else {
                        pg8::StaticOrder S; S.init(MS, D, 128, bx - 128);
                        pg8::Gemm g{(const pg8::bf16_t*)(C.ws + WS_YC_OF(s)), (const pg8::bf16_t*)(C.ws + WS_WBC), MS, D, 1024}; EpiPart E{G + (size_t)2 * MS * 1024, P + (size_t)2 * MS * 1024};
                        pg8::gemm_phase<EpiPart, pg8::StaticOrder, true, true>(C.lds, g, S, E);
                        if (s == NSPLIT - 1) {
                            Ctx Ct = C; Ct.gw = (bx - 128) * NWAVES + C.wave; Ct.NGW = 128 * NWAVES;
                            const size_t wo = (size_t)l * D * FF;
                            ffn_transposes(Ct, INP(23) + wo, INP(24) + wo, INP(25) + wo);
                        }
                    }
                } else {
                    pg8::StaticOrder S; S.init(MS, D, C.G, bx);
                    { pg8::Gemm g{(const pg8::bf16_t*)(C.ws + WS_YA), (const pg8::bf16_t*)(C.ws + WS_WBA), MS, D, 1024}; EpiPart E{G, P};
                      pg8::gemm_phase<EpiPart, pg8::StaticOrder, true, true>(C.lds, g, S, E); }
                    { pg8::Gemm g{(const pg8::bf16_t*)(C.ws + WS_YB), (const pg8::bf16_t*)(C.ws + WS_WBB), MS, D, 768}; EpiPart E{G + (size_t)MS * 1024, P + (size_t)MS * 1024};
                      pg8::gemm_phase<EpiPart, pg8::StaticOrder, true, true>(C.lds, g, S, E); }
                    { pg8::Gemm g{(const pg8::bf16_t*)(C.ws + WS_YC_OF(s)), (const pg8::bf16_t*)(C.ws + WS_WBC), MS, D, 1024}; EpiPart E{G + (size_t)2 * MS * 1024, P + (size_t)2 * MS * 1024};
                      pg8::gemm_phase<EpiPart, pg8::StaticOrder, true, true>(C.lds, g, S, E); }
                }
            } else {
                const v4u* P = (const v4u*)(C.ws + WS_DQ); v4u* Y = (v4u*)(C.ws + WS_YC_OF(s)); const size_t n16 = (size_t)MS * D / 8;
                for (size_t i = (size_t)bx * NTHREADS + C.tid; i < n16; i += (size_t)C.G * NTHREADS) {
                    const v4u a = P[i], b = P[i + n16], c = P[i + 2 * n16]; float x[8], y[8], z[8]; unpack8(a, x); unpack8(b, y); unpack8(c, z);
#pragma unroll
                    for (int e = 0; e < 8; ++e) x[e] = (x[e] + y[e]) + z[e];
                    Y[i] = __builtin_bit_cast(v4u, pack8(x));
                }
            }
        }
        }
        if (ph + 1 < args.ph_hi) grid.sync();
#ifdef PROBE_SYNC
        grid.sync(); grid.sync(); grid.sync();
#endif
    }
}

#ifndef MK_PER_PHASE
#define MK_PER_PHASE 0
#endif
extern "C" void kernel_launch(void* const* d_in, const int* in_sizes, int n_in, void* d_out, int out_size, void* d_ws, size_t ws_size, hipStream_t stream) {
    static int grid = 0;
    if (grid == 0) {
        if (n_in != 26 || out_size != M * D || ws_size < WS_END) { fprintf(stderr, "kernel_launch: unexpected shapes (n_in %d out %d ws %zu)\n", n_in, out_size, ws_size); grid = -1; return; }
        int dev = 0, cus = 0, per_cu = 0;
        hipGetDevice(&dev); hipDeviceGetAttribute(&cus, hipDeviceAttributeMultiprocessorCount, dev);
        if (hipFuncSetAttribute((const void*)fwd_kernel, hipFuncAttributeMaxDynamicSharedMemorySize, LDS_BYTES) != hipSuccess) { fprintf(stderr, "kernel_launch: hipFuncSetAttribute failed\n"); grid = -1; return; }
        if (hipOccupancyMaxActiveBlocksPerMultiprocessor(&per_cu, (const void*)fwd_kernel, NTHREADS, LDS_BYTES) != hipSuccess || per_cu < 1) { fprintf(stderr, "kernel_launch: occupancy query says %d\n", per_cu); per_cu = 1; }
        (void)hipGetLastError();
        grid = cus * (per_cu > 1 ? 1 : per_cu);
        fprintf(stderr, "kernel_launch: grid %d (cus %d per_cu %d)\n", grid, cus, per_cu);
    }
    if (grid < 0) return;
    Args a{};
    for (int i = 0; i < 26; ++i) a.in[i] = (const float*)d_in[i];
    a.out = (float*)d_out; a.ws = (unsigned char*)d_ws;
#if MK_PER_PHASE
    for (int ph = 0; ph < N_PHASES; ++ph) {
        a.ph_lo = ph; a.ph_hi = ph + 1; void* kargs[] = {&a};
        hipError_t e = hipLaunchCooperativeKernel((const void*)fwd_kernel, dim3(grid), dim3(NTHREADS), kargs, LDS_BYTES, stream);
        if (e != hipSuccess) { fprintf(stderr, "cooperative launch failed: %s\n", hipGetErrorString(e)); break; }
    }
#else
    a.ph_lo = 0; a.ph_hi = N_PHASES; void* kargs[] = {&a};
    hipError_t e = hipLaunchCooperativeKernel((const void*)fwd_kernel, dim3(grid), dim3(NTHREADS), kargs, LDS_BYTES, stream);
    if (e != hipSuccess) fprintf(stderr, "cooperative launch failed: %s\n", hipGetErrorString(e));
#endif
}
```

```cpp
#include <hip/hip_runtime.h>
#include <hip/hip_cooperative_groups.h>
#include <cstdio>
#include <cstdint>
namespace cg = cooperative_groups;
namespace pg8 {
#define PG8_LAS __attribute__((address_space(3)))
typedef unsigned short bf16_t;
typedef short bf16x8 __attribute__((ext_vector_type(8)));
typedef float f32x4 __attribute__((ext_vector_type(4)));
typedef unsigned u32x4 __attribute__((ext_vector_type(4)));
constexpr int BM = 256, BK = 64, HALF = 128, HTB = HALF * BK * 2  , STAGE_BYTES = 8 * HTB, NXCD = 8, WGM = 4;

__host__ __device__ __forceinline__ int lds_byte(int r, int c) { const int st = (r >> 4) * 2 + (c >> 5), rr = r & 15, cc = c & 31, ob = rr * 64 + cc * 2; return st * 1024 + (ob ^ (((ob >> 9) & 1) << 5)); }
__host__ __device__ __forceinline__ void stage_rc(int b, int& R, int& C) { const int st = b / 1024, sb = b % 1024, swz = sb ^ (((sb >> 9) & 1) << 5); R = (st >> 1) * 16 + swz / 64; C = (st & 1) * 32 + (swz % 64) / 2; }
__host__ __device__ __forceinline__ int perm32(int rho) { const int n = rho >> 4, i = rho & 15; return 8 * (i >> 2) + 4 * n + (i & 3); }

struct Unit { int pm, pn; };
struct Gemm { const bf16_t* A; const bf16_t* Bt; int M, N, K; };

struct StaticOrder {
    int nM, nN, nwg, G, c;
    __host__ __device__ void init(int M, int N, int G_, int c_) { nM = M / BM; nN = N / BM; nwg = nM * nN; G = G_; c = c_; }
    __host__ __device__ bool next(int i, Unit& u) const {
        const long L = (long)i * G + c; if (L >= nwg) return false;
        int wgid = (int)L; { const int q = nwg / NXCD, r = nwg % NXCD, xcd = wgid % NXCD, off = wgid / NXCD; wgid = (xcd < r ? xcd * (q + 1) : r * (q + 1) + (xcd - r) * q) + off; }
        const int nig = WGM * nN, gid = wgid / nig, fm = gid * WGM, gsz = (nM - fm) < WGM ? (nM - fm) : WGM;
        u.pm = fm + ((wgid % nig) % gsz); u.pn = (wgid % nig) / gsz; return true;
    }
    __device__ __forceinline__ void a_ready(const Unit&) const {}
    __device__ __forceinline__ void done(const Unit&) const {}
};

template <class Epi, class Sched, bool ALIGN_EPI = false, bool SP2 = false>
__device__ __forceinline__ void gemm_phase(PG8_LAS unsigned char* lds, const Gemm g, const Sched& S, const Epi& E) {
    int tid_ = threadIdx.x; asm volatile("" : "+v"(tid_));
    const int tid = tid_, wid = __builtin_amdgcn_readfirstlane(tid >> 6), lane = tid & 63, wr = wid >> 2, wc = wid & 3, fr = lane & 15, fq = lane >> 4;
    const int K = g.K, nt = K / BK;
    unsigned voffA[2], voffB[2];
#pragma unroll
    for (int i = 0; i < 2; ++i) { int R, C; stage_rc(tid * 16 + i * 8192, R, C); const int Rb = Epi::PERM ? ((R & ~31) + perm32(R & 31)) : R;
        voffA[i] = (unsigned)(R * K + C) * 2u; voffB[i] = (unsigned)(Rb * K + C) * 2u; }
    const size_t kstep = (size_t)(BK * 2);
    const size_t hstep = (size_t)HALF * K * 2;
    const size_t tstep = 2 * hstep;
    const unsigned ldsw = (unsigned)wid * 1024u;
    const int aoff = lds_byte(wr * 64 + fr, fq * 8), boff = lds_byte(wc * 32 + fr, fq * 8);
#define PG8_SA(b, h) (((b) * 2 + (h)) * HTB)
#define PG8_SB(b, h) ((4 + (b) * 2 + (h)) * HTB)
#define PG8_STAGE(bufoff, gbase, voff) do { _Pragma("unroll") for (int _i = 0; _i < 2; ++_i) \
        __builtin_amdgcn_global_load_lds((const unsigned*)((const char*)(gbase) + (voff)[_i]), (PG8_LAS unsigned*)(lds + (bufoff) + ldsw + _i * 8192), 16, 0, 0); } while (0)
#define PG8_LDA(dst, b, h) do { _Pragma("unroll") for (int m = 0; m < 4; ++m) _Pragma("unroll") for (int k = 0; k < 2; ++k) dst[m][k] = *(const PG8_LAS bf16x8*)(lds + PG8_SA(b, h) + aoff + m * 2048 + k * 1024); } while (0)
#define PG8_LDB(dst, b, h) do { _Pragma("unroll") for (int n = 0; n < 2; ++n) _Pragma("unroll") for (int k = 0; k < 2; ++k) dst[n][k] = *(const PG8_LAS bf16x8*)(lds + PG8_SB(b, h) + boff + n * 2048 + k * 1024); } while (0)
#define PG8_MMA(ai, bj, At, Bt) do { __builtin_amdgcn_s_setprio(1); _Pragma("unroll") for (int m = 0; m < 4; ++m) _Pragma("unroll") for (int n = 0; n < 2; ++n) _Pragma("unroll") for (int k = 0; k < 2; ++k) \
        acc[ai][bj][m][n] = __builtin_amdgcn_mfma_f32_16x16x32_bf16(Bt[n][k], At[m][k], acc[ai][bj][m][n], 0, 0, 0); __builtin_amdgcn_s_setprio(0); } while (0)
#define PG8_WAIT_V(n) asm volatile("s_waitcnt vmcnt(" #n ")" ::: "memory")
#define PG8_WAIT_L(n) asm volatile("s_waitcnt lgkmcnt(" #n ")" ::: "memory")
#define PG8_BAR __builtin_amdgcn_s_barrier()
#define PG8_SCHED __builtin_amdgcn_sched_barrier(0)
    Unit cur, nxt; int ui = 0;
    if (!S.next(0, cur)) return;
    f32x4 acc[2][2][4][2];
#pragma unroll
    for (int a = 0; a < 2; ++a)
#pragma unroll
        for (int b = 0; b < 2; ++b)
#pragma unroll
            for (int m = 0; m < 4; ++m)
#pragma unroll
                for (int n = 0; n < 2; ++n) acc[a][b][m][n] = (f32x4){0.f, 0.f, 0.f, 0.f};
    bf16x8 At[4][2], B0[2][2], B1[2][2];
    const char* cA = (const char*)g.A + (size_t)cur.pm * tstep; const char* cB = (const char*)g.Bt + (size_t)cur.pn * tstep;
    S.a_ready(cur);
    if constexpr (SP2) {
        PG8_STAGE(PG8_SB(0, 0), cB, voffB); PG8_STAGE(PG8_SB(0, 1), cB + hstep, voffB); PG8_STAGE(PG8_SA(0, 0), cA, voffA); PG8_STAGE(PG8_SA(0, 1), cA + hstep, voffA);
        if (wr == 1) PG8_BAR;
        PG8_WAIT_V(2); PG8_BAR;
        PG8_STAGE(PG8_SB(1, 0), cB + kstep, voffB); PG8_STAGE(PG8_SA(1, 0), cA + kstep, voffA); PG8_STAGE(PG8_SB(1, 1), cB + hstep + kstep, voffB);
        PG8_WAIT_V(6); PG8_BAR;
    } else {
        PG8_STAGE(PG8_SB(0, 0), cB, voffB); PG8_STAGE(PG8_SA(0, 0), cA, voffA); PG8_STAGE(PG8_SB(0, 1), cB + hstep, voffB); PG8_STAGE(PG8_SA(0, 1), cA + hstep, voffA);
        if (wr == 1) PG8_BAR;
        PG8_WAIT_V(4); PG8_BAR;
        PG8_STAGE(PG8_SB(1, 0), cB + kstep, voffB); PG8_STAGE(PG8_SA(1, 0), cA + kstep, voffA); PG8_STAGE(PG8_SB(1, 1), cB + hstep + kstep, voffB);
        PG8_WAIT_V(6); PG8_BAR;
    }
    for (;;) {
        const bool has_next = S.next(ui + 1, nxt);
        const char* nA = has_next ? (const char*)g.A + (size_t)nxt.pm * tstep : cA; const char* nB = has_next ? (const char*)g.Bt + (size_t)nxt.pn * tstep : cB;
        for (int t = 0; t < nt; t += 2) {
            const bool last = (t == nt - 2);
            const char* a1 = cA + (size_t)(t + 1) * kstep;
            const char* a2 = last ? nA : cA + (size_t)(t + 2) * kstep; const char* b2 = last ? nB : cB + (size_t)(t + 2) * kstep;
            const char* a3 = a2 + kstep; const char* b3 = b2 + kstep;
            if (last && has_next) S.a_ready(nxt);
            if constexpr (SP2) {
            PG8_LDB(B0, 0, 0); PG8_LDB(B1, 0, 1); PG8_SCHED; PG8_LDA(At, 0, 0); PG8_STAGE(PG8_SA(1, 1), a1 + hstep, voffA);
            PG8_WAIT_V(8); PG8_WAIT_L(0); PG8_BAR; PG8_MMA(0, 0, At, B0); PG8_MMA(0, 1, At, B1); PG8_BAR; PG8_SCHED;
            PG8_LDA(At, 0, 1); PG8_STAGE(PG8_SB(0, 0), b2, voffB); PG8_STAGE(PG8_SB(0, 1), b2 + hstep, voffB); PG8_STAGE(PG8_SA(0, 0), a2, voffA);
            PG8_WAIT_V(8); PG8_WAIT_L(0); PG8_BAR; PG8_MMA(1, 0, At, B0); PG8_MMA(1, 1, At, B1); PG8_BAR; PG8_SCHED;
            PG8_LDB(B0, 1, 0); PG8_LDB(B1, 1, 1); PG8_SCHED; PG8_LDA(At, 1, 0); PG8_STAGE(PG8_SA(0, 1), a2 + hstep, voffA);
            PG8_WAIT_V(8); PG8_WAIT_L(0); PG8_BAR; PG8_MMA(0, 0, At, B0); PG8_MMA(0, 1, At, B1); PG8_BAR; PG8_SCHED;
            PG8_LDA(At, 1, 1); PG8_STAGE(PG8_SB(1, 0), b3, voffB); PG8_STAGE(PG8_SB(1, 1), b3 + hstep, voffB); PG8_STAGE(PG8_SA(1, 0), a3, voffA);
            PG8_WAIT_V(8); PG8_WAIT_L(0); PG8_BAR; PG8_MMA(1, 0, At, B0); PG8_MMA(1, 1, At, B1); PG8_BAR; PG8_SCHED;
            } else {
            PG8_LDB(B0, 0, 0); PG8_SCHED; PG8_LDA(At, 0, 0); PG8_STAGE(PG8_SA(1, 1), a1 + hstep, voffA);
            PG8_WAIT_L(8); PG8_BAR; PG8_WAIT_L(0); PG8_MMA(0, 0, At, B0); PG8_BAR; PG8_SCHED;
            PG8_LDB(B1, 0, 1); PG8_STAGE(PG8_SB(0, 0), b2, voffB);
            PG8_BAR; PG8_WAIT_L(0); PG8_MMA(0, 1, At, B1); PG8_BAR;
            PG8_LDA(At, 0, 1); PG8_STAGE(PG8_SA(0, 0), a2, voffA);
            PG8_BAR; PG8_WAIT_L(0); PG8_MMA(1, 0, At, B0); PG8_BAR; PG8_SCHED;
            PG8_STAGE(PG8_SB(0, 1), b2 + hstep, voffB);
            PG8_WAIT_V(6); PG8_BAR; PG8_MMA(1, 1, At, B1); PG8_BAR;
            PG8_LDB(B0, 1, 0); PG8_SCHED; PG8_LDA(At, 1, 0); PG8_STAGE(PG8_SA(0, 1), a2 + hstep, voffA);
            PG8_WAIT_L(8); PG8_BAR; PG8_WAIT_L(0); PG8_MMA(0, 0, At, B0); PG8_BAR; PG8_SCHED;
            PG8_LDB(B1, 1, 1); PG8_STAGE(PG8_SB(1, 0), b3, voffB);
            PG8_BAR; PG8_WAIT_L(0); PG8_MMA(0, 1, At, B1); PG8_BAR;
            PG8_LDA(At, 1, 1); PG8_STAGE(PG8_SA(1, 0), a3, voffA);
            PG8_BAR; PG8_WAIT_L(0); PG8_MMA(1, 0, At, B0); PG8_BAR; PG8_SCHED;
            PG8_STAGE(PG8_SB(1, 1), b3 + hstep, voffB);
            PG8_WAIT_V(6); PG8_BAR; PG8_MMA(1, 1, At, B1); PG8_BAR;
            }
        }
        if constexpr (ALIGN_EPI) { if (wr == 0) PG8_BAR; }
        if constexpr (!Epi::AFTER_DRAIN) { E(acc, cur, wr, wc, fr, fq); S.done(cur); }
        if (!has_next) break;
#pragma unroll
        for (int a = 0; a < 2; ++a)
#pragma unroll
            for (int b = 0; b < 2; ++b)
#pragma unroll
                for (int m = 0; m < 4; ++m)
#pragma unroll
                    for (int n = 0; n < 2; ++n) acc[a][b][m][n] = (f32x4){0.f, 0.f, 0.f, 0.f};
        cur = nxt; cA = nA; cB = nB; ++ui;
        if constexpr (ALIGN_EPI) { if (wr == 1) PG8_BAR; }
    }
    PG8_WAIT_V(0);
    if constexpr (!ALIGN_EPI) { if (wr == 0) PG8_BAR; }
    PG8_BAR;
    if constexpr (Epi::AFTER_DRAIN) { E.fused(acc, cur, wr, wc, fr, fq, lds, wid, lane); S.done(cur); }
#undef PG8_SA
#undef PG8_SB
#undef PG8_STAGE
#undef PG8_LDA
#undef PG8_LDB
#undef PG8_MMA
#undef PG8_WAIT_V
#undef PG8_WAIT_L
#undef PG8_BAR
#undef PG8_SCHED
}
}

#define GAS __attribute__((address_space(1)))
#define LAS __attribute__((address_space(3)))
typedef unsigned short bf16;
typedef unsigned v4u __attribute__((ext_vector_type(4)));
typedef unsigned v2u __attribute__((ext_vector_type(2)));
typedef float f32x4 __attribute__((ext_vector_type(4)));
typedef float f32x2 __attribute__((ext_vector_type(2)));
typedef short bf16x8 __attribute__((ext_vector_type(8)));

constexpr int NWAVES = 8, NTHREADS = 512;
constexpr int BATCH = 8, SEQ = 2048, D = 1024, FF = 2816, M = BATCH * SEQ, DEPTH = 2;
constexpr int NSPLIT = 2, MS = M / NSPLIT, BS = BATCH / NSPLIT;
constexpr int IN_DIM = 11536, NPROJ = 11520;
constexpr int ATT_W = 768, NHEAD = 12, HD = 64;
constexpr int DNH = 8, DNK = 128;
constexpr float EPS = 1e-6f;

constexpr size_t MiB = 1u << 20;
constexpr size_t WS_CTL = 0;
constexpr size_t WS_WT = 1 * MiB;
constexpr size_t WS_W1T = WS_WT, WS_W2T = WS_WT + 11 * MiB;
constexpr size_t WS_WINT = WS_WT, WS_WBA = 24 * MiB, WS_WBB = 26 * MiB, WS_WBC = 28 * MiB, WS_WOUT = 30 * MiB;
constexpr size_t WS_XN = 32 * MiB;
constexpr size_t WS_BA = 64 * MiB;
constexpr size_t WS_LSE = 65 * MiB;
constexpr size_t WS_H = 66 * MiB;
constexpr size_t WS_RGX = 66 * MiB, WS_RGG = 82 * MiB, WS_AQ = 98 * MiB, WS_AK = 110 * MiB, WS_AV = 122 * MiB;
constexpr size_t WS_DQ = 134 * MiB, WS_DK = 150 * MiB, WS_DV = 166 * MiB, WS_DZ = 182 * MiB, WS_GATE = 198 * MiB;
constexpr size_t WS_U0T = 246 * MiB, WS_WK = 278 * MiB, WS_QD = 294 * MiB, WS_KDT = 310 * MiB, WS_QK = 326 * MiB;
constexpr size_t WS_YA = 334 * MiB, WS_SST = 350 * MiB, WS_END = 352 * MiB;
constexpr size_t WS_YB = WS_AQ, WS_YM = WS_DQ, WS_Y = WS_DV;
#define WS_YC_OF(s_) (WS_XN + (size_t)(s_) * MS * D * 2)
constexpr int LDS_BYTES = 147456;

typedef __bf16 hwbf16x2 __attribute__((ext_vector_type(2)));
__device__ __forceinline__ unsigned pk2(float lo, float hi) { const f32x2 v = {lo, hi}; return __builtin_bit_cast(unsigned, __builtin_convertvector(v, hwbf16x2)); }
__device__ __forceinline__ unsigned f2bf(float f) { return pk2(f, 0.f) & 0xffffu; }
__device__ __forceinline__ float bf2f(unsigned h) { return __builtin_bit_cast(float, h << 16); }
__device__ __forceinline__ float bflo(unsigned w) { return __builtin_bit_cast(float, w << 16); }
__device__ __forceinline__ float bfhi(unsigned w) { return __builtin_bit_cast(float, w & 0xffff0000u); }
__device__ __forceinline__ float fsigmoid(float v) { return __builtin_amdgcn_rcpf(1.f + __expf(-v)); }
__device__ __forceinline__ float fsilu(float v) { return v * fsigmoid(v); }
__device__ __forceinline__ float fgelu_tanh(float v) { const float u = 0.7978845608028654f * (v + 0.044715f * v * v * v); return v * fsigmoid(2.f * u); }
__device__ __forceinline__ float fsoftplus(float v) { return v > 20.f ? v : log1pf(__expf(v)); }
__device__ __forceinline__ float wave_sum(float v) {
#pragma unroll
    for (int o = 1; o < 64; o <<= 1) v += __shfl_xor(v, o);
    return v;
}
#define LDS_WAIT() asm volatile("s_waitcnt lgkmcnt(0)" ::: "memory")
template <int CTRL> __device__ __forceinline__ float dpp_mov(float v) { return __builtin_bit_cast(float, __builtin_amdgcn_update_dpp(0, __builtin_bit_cast(int, v), CTRL, 0xf, 0xf, false)); }
__device__ __forceinline__ float row16_sum(float v) { v += dpp_mov<0x128>(v); v += dpp_mov<0x124>(v); v += dpp_mov<0x122>(v); v += dpp_mov<0x121>(v); return v; }
__device__ __forceinline__ float row16_max(float v) { v = fmaxf(v, dpp_mov<0x128>(v)); v = fmaxf(v, dpp_mov<0x124>(v)); v = fmaxf(v, dpp_mov<0x122>(v)); v = fmaxf(v, dpp_mov<0x121>(v)); return v; }

using pg8::Unit;
typedef pg8::f32x4 (AccT)[2][2][4][2];
struct EpiFfnUp {
    static constexpr bool PERM = true, AFTER_DRAIN = false; bf16* H;
    __device__ __forceinline__ void operator()(const pg8::f32x4 (&acc)[2][2][4][2], const Unit& u, int wr, int wc, int fr, int fq) const {
        const int row0 = u.pm * 256 + wr * 64 + fr, col0 = u.pn * 128 + wc * 32 + 8 * fq;
#pragma unroll
        for (int ai = 0; ai < 2; ++ai)
#pragma unroll
            for (int m = 0; m < 4; ++m) {
                bf16* p = H + (size_t)(row0 + ai * 128 + m * 16) * FF + col0;
                float h[8];
#pragma unroll
                for (int n = 0; n < 2; ++n)
#pragma unroll
                    for (int e = 0; e < 4; ++e) h[n * 4 + e] = fsilu(acc[ai][0][m][n][e]) * acc[ai][1][m][n][e];
                v4u w; w.x = pk2(h[0], h[1]); w.y = pk2(h[2], h[3]); w.z = pk2(h[4], h[5]); w.w = pk2(h[6], h[7]);
                *(v4u*)p = w;
            }
    }
};
struct EpiResid {
    static constexpr bool PERM = false, AFTER_DRAIN = false; float* X; float scale; const float* Xsrc;
    __device__ __forceinline__ void operator()(const pg8::f32x4 (&acc)[2][2][4][2], const Unit& u, int wr, int wc, int fr, int fq) const {
        const int row0 = u.pm * 256 + wr * 64 + fr, col0 = u.pn * 256 + wc * 32 + 4 * fq; const ptrdiff_t sd = Xsrc - X;
#pragma unroll
        for (int ai = 0; ai < 2; ++ai)
#pragma unroll
            for (int m = 0; m < 4; ++m) {
                float* p = X + (size_t)(row0 + ai * 128 + m * 16) * D + col0;
#pragma unroll
                for (int bj = 0; bj < 2; ++bj)
#pragma unroll
                    for (int n = 0; n < 2; ++n) { f32x4* q = (f32x4*)(p + bj * 128 + n * 16); f32x4 v = *(const f32x4*)((const float*)q + sd); v = v + acc[ai][bj][m][n] * scale; *q = v; }
                asm volatile("" ::: "memory");
            }
    }
};
struct EpiInProj {
    static constexpr bool PERM = true, AFTER_DRAIN = false; unsigned char* ws;
    __device__ __forceinline__ void operator()(const pg8::f32x4 (&acc)[2][2][4][2], const Unit& u, int wr, int wc, int fr, int fq) const {
        const int pn = u.pn; size_t off; int t0, width, act = 0;
        if (pn < 4) { off = WS_RGX; t0 = 0; width = 1024; }
        else if (pn < 8) { off = WS_RGG; t0 = 4; width = 1024; act = 1; }
        else if (pn < 11) { off = WS_AQ; t0 = 8; width = 768; }
        else if (pn < 14) { off = WS_AK; t0 = 11; width = 768; }
        else if (pn < 17) { off = WS_AV; t0 = 14; width = 768; }
        else if (pn < 21) { off = WS_DQ; t0 = 17; width = 1024; }
        else if (pn < 25) { off = WS_DK; t0 = 21; width = 1024; }
        else if (pn < 29) { off = WS_DV; t0 = 25; width = 1024; }
        else if (pn < 33) { off = WS_DZ; t0 = 29; width = 1024; act = 2; }
        else { const int g = (pn - 33) >> 2; off = WS_GATE + (size_t)g * MS * 1024 * 2; t0 = 33 + 4 * g; width = 1024; act = 3; }
        bf16* base = (bf16*)(ws + off) + (size_t)(u.pm * 256 + wr * 64 + fr) * width + (pn - t0) * 256 + wc * 32 + 8 * fq;
        if (act == 0) store<false>(acc, base, width, 0); else store<true>(acc, base, width, act);
    }
    template <bool ACT> static __device__ __forceinline__ void store(const pg8::f32x4 (&acc)[2][2][4][2], bf16* base, int width, int act) {
        const bool is_gelu = act == 1, is_sig = act == 3;
#pragma unroll
        for (int ai = 0; ai < 2; ++ai)
#pragma unroll
            for (int m = 0; m < 4; ++m) {
                bf16* p = base + (size_t)(ai * 128 + m * 16) * width;
#pragma unroll
                for (int bj = 0; bj < 2; ++bj) {
                    float h[8];
#pragma unroll
                    for (int n = 0; n < 2; ++n)
#pragma unroll
                        for (int e = 0; e < 4; ++e) { float v = acc[ai][bj][m][n][e];
                            if (ACT) { const float zg = 1.5957691216057308f * (v + 0.044715f * v * v * v); const float z = is_gelu ? zg : v; const float sg = fsigmoid(z); v = is_sig ? sg : v * sg; }
                            h[n * 4 + e] = v; }
                    v4u w; w.x = pk2(h[0], h[1]); w.y = pk2(h[2], h[3]); w.z = pk2(h[4], h[5]); w.w = pk2(h[6], h[7]);
                    *(v4u*)(p + bj * 128) = w;
                }
            }
    }
};
template <int BR> struct EpiMerge {
    static constexpr bool PERM = true, AFTER_DRAIN = false; const bf16* G; float* Ym; bf16* Y;
    __device__ __forceinline__ void operator()(const pg8::f32x4 (&acc)[2][2][4][2], const Unit& u, int wr, int wc, int fr, int fq) const {
        const int row0 = u.pm * 256 + wr * 64 + fr, col0 = u.pn * 256 + wc * 32 + 8 * fq;
#pragma unroll
        for (int ai = 0; ai < 2; ++ai)
#pragma unroll
            for (int m = 0; m < 4; ++m) {
                const size_t ro = (size_t)(row0 + ai * 128 + m * 16) * D + col0;
#pragma unroll
                for (int bj = 0; bj < 2; ++bj) {
                    const v4u g = *(const v4u*)(G + ro + bj * 128);
                    f32x4 a0 = acc[ai][bj][m][0], a1 = acc[ai][bj][m][1];
                    a0[0] *= bflo(g.x); a0[1] *= bfhi(g.x); a0[2] *= bflo(g.y); a0[3] *= bfhi(g.y);
                    a1[0] *= bflo(g.z); a1[1] *= bfhi(g.z); a1[2] *= bflo(g.w); a1[3] *= bfhi(g.w);
                    f32x4* q = (f32x4*)(Ym + ro + bj * 128);
                    if (BR >= 1) { a0 = a0 + q[0]; a1 = a1 + q[1]; }
                    if (BR <= 1) { q[0] = a0; q[1] = a1; }
                    else { v4u w; w.x = pk2(a0[0], a0[1]); w.y = pk2(a0[2], a0[3]); w.z = pk2(a1[0], a1[1]); w.w = pk2(a1[2], a1[3]); *(v4u*)(Y + ro + bj * 128) = w; }
                }
                asm volatile("" ::: "memory");
            }
    }
};

struct EpiPart {
    static constexpr bool PERM = true, AFTER_DRAIN = false; const bf16* G; bf16* P;
    __device__ __forceinline__ void operator()(const pg8::f32x4 (&acc)[2][2][4][2], const Unit& u, int wr, int wc, int fr, int fq) const {
        const int row0 = u.pm * 256 + wr * 64 + fr, col0 = u.pn * 256 + wc * 32 + 8 * fq;
#pragma unroll
        for (int ai = 0; ai < 2; ++ai)
#pragma unroll
            for (int m = 0; m < 4; ++m) {
                const size_t ro = (size_t)(row0 + ai * 128 + m * 16) * D + col0;
#pragma unroll
                for (int bj = 0; bj < 2; ++bj) {
                    const v4u g = *(const v4u*)(G + ro + bj * 128);
                    const f32x4 a0 = acc[ai][bj][m][0], a1 = acc[ai][bj][m][1];
                    v4u w; w.x = pk2(a0[0] * bflo(g.x), a0[1] * bfhi(g.x)); w.y = pk2(a0[2] * bflo(g.y), a0[3] * bfhi(g.y));
                    w.z = pk2(a1[0] * bflo(g.z), a1[1] * bfhi(g.z)); w.w = pk2(a1[2] * bflo(g.w), a1[3] * bfhi(g.w));
                    *(v4u*)(P + ro + bj * 128) = w;
                }
            }
    }
};

struct Ctx {
    LAS unsigned char* lds; unsigned char* ldsg;
    int tid, lane, wave, G, gw, NGW;
    unsigned char* ws; float* x;
};
__device__ __forceinline__ Ctx relaunder(const Ctx& C0) {
    Ctx R = C0; int t_ = C0.tid; unsigned long long w_ = (unsigned long long)C0.ws; asm volatile("" : "+v"(t_), "+s"(w_));
    R.tid = t_; R.lane = t_ & 63; R.wave = __builtin_amdgcn_readfirstlane(t_ >> 6); R.ws = (unsigned char*)(GAS unsigned char*)w_; return R;
}
constexpr int PTAB_OFF = 147456 - 512;
#define INP(i) (ld_inp(C, (i)))
__device__ __forceinline__ const float* ld_inp(const Ctx& C, int i) {
    const unsigned long long v = *(const LAS unsigned long long*)(C.lds + PTAB_OFF + 8 * i);
    const unsigned lo = __builtin_amdgcn_readfirstlane((unsigned)v), hi = __builtin_amdgcn_readfirstlane((unsigned)(v >> 32));
    return (const float*)(GAS const float*)(((unsigned long long)hi << 32) | lo);
}
struct TrIt { const float* W; bf16* WT; int ldw, K, k0, n0, drow0; };
__device__ __forceinline__ void tr_load(const TrIt& t, float (&tv)[32], int lane) {
#pragma unroll
    for (int i = 0; i < 32; ++i) tv[i] = t.W[(size_t)(t.k0 + 2 * i + (lane >> 5)) * t.ldw + t.n0 + (lane & 31)];
}
__device__ __forceinline__ void tr_finish(const TrIt& t, const float (&tv)[32], LAS float* scr, int lane) {
#pragma unroll
    for (int i = 0; i < 32; ++i) scr[(2 * i + (lane >> 5)) * 33 + (lane & 31)] = tv[i];
    LDS_WAIT(); asm volatile("" ::: "memory");
    const int c = lane & 7;
#pragma unroll
    for (int j = 0; j < 4; ++j) { const int n = (lane >> 3) + 8 * j; const LAS float* s = scr + (8 * c) * 33 + n;
        v4u o; o.x = pk2(s[0 * 33], s[1 * 33]); o.y = pk2(s[2 * 33], s[3 * 33]); o.z = pk2(s[4 * 33], s[5 * 33]); o.w = pk2(s[6 * 33], s[7 * 33]);
        *(v4u*)(t.WT + (size_t)(t.drow0 + n) * t.K + t.k0 + 8 * c) = o; }
    LDS_WAIT(); asm volatile("" ::: "memory");
}
template <class Dec> __device__ __forceinline__ void run_transposes(const Ctx& C, const Dec& dec, int nitems, LAS float* scr) {
    int it = C.gw; if (it >= nitems) return;
    TrIt cur = dec(it); float tv[32]; tr_load(cur, tv, C.lane);
    for (;;) {
        const int nx = it + C.NGW; const bool has = nx < nitems;
        TrIt nxt = dec(has ? nx : it); float tn[32];
        tr_load(nxt, tn, C.lane);
        tr_finish(cur, tv, scr, C.lane);
        if (!has) break;
        cur = nxt; it = nx;
#pragma unroll
        for (int i = 0; i < 32; ++i) tv[i] = tn[i];
    }
}
__device__ __forceinline__ void norm_rows(const Ctx& C, const float* g, bf16* XN, const LAS float* Wl, float* BA) {
    f32x4 gv[4];
#pragma unroll
    for (int j = 0; j < 4; ++j) gv[j] = *((const f32x4*)g + C.lane + 64 * j);
    f32x4 vn[2][4];
#pragma unroll
    for (int rr = 0; rr < 2; ++rr) { const int m = min(C.gw + rr * C.NGW, M - 1); const f32x4* xr = (const f32x4*)(C.x + (size_t)m * D) + C.lane;
#pragma unroll
        for (int j = 0; j < 4; ++j) vn[rr][j] = xr[64 * j]; }
    for (int m0 = C.gw; m0 < M; m0 += 2 * C.NGW) {
        f32x4 v[2][4]; float s[2] = {0.f, 0.f};
#pragma unroll
        for (int rr = 0; rr < 2; ++rr)
#pragma unroll
            for (int j = 0; j < 4; ++j) v[rr][j] = vn[rr][j];
#pragma unroll
        for (int rr = 0; rr < 2; ++rr) { const int m = min(m0 + (2 + rr) * C.NGW, M - 1); const f32x4* xr = (const f32x4*)(C.x + (size_t)m * D) + C.lane;
#pragma unroll
            for (int j = 0; j < 4; ++j) vn[rr][j] = xr[64 * j]; }
#pragma unroll
        for (int rr = 0; rr < 2; ++rr) { const int m = m0 + rr * C.NGW; if (m >= M) break;
#pragma unroll
            for (int j = 0; j < 4; ++j) s[rr] += (v[rr][j].x * v[rr][j].x + v[rr][j].y * v[rr][j].y) + (v[rr][j].z * v[rr][j].z + v[rr][j].w * v[rr][j].w);
            const float rstd = rsqrtf(wave_sum(s[rr]) * (1.f / D) + EPS);
            unsigned long long* o8 = (unsigned long long*)(XN + (size_t)m * D) + C.lane;
#pragma unroll
            for (int j = 0; j < 4; ++j) { v[rr][j] = v[rr][j] * rstd * gv[j]; o8[64 * j] = (unsigned long long)pk2(v[rr][j].x, v[rr][j].y) | ((unsigned long long)pk2(v[rr][j].z, v[rr][j].w) << 32); }
            if (BA) {
                asm volatile("" ::: "memory");
                float mine = 0.f;
#pragma unroll
                for (int c = 0; c < 16; ++c) {
                    float a = 0.f;
#pragma unroll
                    for (int j = 0; j < 4; ++j) { const f32x4 w = *((const LAS f32x4*)(Wl + c * 1024) + C.lane + 64 * j); a += (v[rr][j].x * w.x + v[rr][j].y * w.y) + (v[rr][j].z * w.z + v[rr][j].w * w.w); }
                    const float t = wave_sum(a); if (C.lane == c) mine = t;
                }
                if (C.lane < 16) BA[(size_t)m * 16 + C.lane] = mine;
            }
        }
    }
}
__device__ __forceinline__ void ffn_transposes(const Ctx& C, const float* Wg, const float* Wu, const float* Wd) {
    LAS float* scr = (LAS float*)(C.lds + C.wave * 16384);
    bf16* W1T = (bf16*)(C.ws + WS_W1T); bf16* W2T = (bf16*)(C.ws + WS_W2T);
    constexpr int I1 = (D / 64) * (FF / 32), I2 = (FF / 64) * (D / 32);
    auto dec = [=](int it) -> TrIt {
        int r = it; TrIt t;
        if (r < 2 * I1) { const int up = r >= I1; if (up) r -= I1; const int kb = r / (FF / 32), nb = r % (FF / 32), n0 = 32 * nb;
            t.W = up ? Wu : Wg; t.WT = W1T; t.ldw = FF; t.K = D; t.k0 = 64 * kb; t.n0 = n0; t.drow0 = 256 * (n0 >> 7) + 128 * up + (n0 & 127); }
        else { r -= 2 * I1; const int kb = r / (D / 32), nb = r % (D / 32); t.W = Wd; t.WT = W2T; t.ldw = D; t.K = FF; t.k0 = 64 * kb; t.n0 = 32 * nb; t.drow0 = 32 * nb; }
        return t; };
    run_transposes(C, dec, 2 * I1 + I2, scr);
}
__device__ __forceinline__ void prep_ffn(const Ctx& C, const float* Wg, const float* Wu, const float* Wd, const float* gn, bool do_tr) {
    if (do_tr) ffn_transposes(C, Wg, Wu, Wd);
    norm_rows(C, gn, (bf16*)(C.ws + WS_XN), nullptr, nullptr);
}
__device__ __forceinline__ void mix_transposes(const Ctx& C, const float* Win, const float* Wbr, const float* Wout, int first, int count) {
    LAS float* scr = (LAS float*)(C.lds + C.wave * 16384);
    constexpr int NB_IN = NPROJ / 32, I_IN = 16 * NB_IN, I_A = 16 * 32, I_B = 12 * 32, I_C = 16 * 32, I_O = 16 * 32;
    unsigned char* ws_ = C.ws;
    auto dec = [=](int it) -> TrIt {
        int r = it; TrIt t;
        if (r < I_IN) { const int kb = r / NB_IN, nb = r % NB_IN; const int drow = 32 * nb, n0 = drow < 8448 ? drow : drow + 16;
            t.W = Win; t.WT = (bf16*)(ws_ + WS_WINT); t.ldw = IN_DIM; t.K = D; t.k0 = 64 * kb; t.n0 = n0; t.drow0 = drow; return t; }
        r -= I_IN; t.ldw = D; t.k0 = 64 * (r / 32); t.n0 = 32 * (r % 32); t.drow0 = t.n0;
        if (r < I_A) { t.W = Wbr; t.WT = (bf16*)(ws_ + WS_WBA); t.K = 1024; return t; } r -= I_A; t.k0 = 64 * (r / 32); t.n0 = 32 * (r % 32); t.drow0 = t.n0;
        if (r < I_B) { t.W = Wbr + (size_t)1024 * D; t.WT = (bf16*)(ws_ + WS_WBB); t.K = 768; return t; } r -= I_B; t.k0 = 64 * (r / 32); t.n0 = 32 * (r % 32); t.drow0 = t.n0;
        if (r < I_C) { t.W = Wbr + (size_t)1792 * D; t.WT = (bf16*)(ws_ + WS_WBC); t.K = 1024; return t; } r -= I_C; t.k0 = 64 * (r / 32); t.n0 = 32 * (r % 32); t.drow0 = t.n0;
        t.W = Wout; t.WT = (bf16*)(ws_ + WS_WOUT); t.K = 1024; return t; };
    auto dec2 = [=](int it) -> TrIt { return dec(it + first); };
    run_transposes(C, dec2, count, scr);
}
constexpr int MIXTR_IN = 16 * (NPROJ / 32), MIXTR_ALL = MIXTR_IN + 16 * 32 + 12 * 32 + 16 * 32 + 16 * 32;
__device__ __forceinline__ void prep_mix(const Ctx& C, const float* Win, const float* Wbr, const float* Wout, const float* gn) {
    mix_transposes(C, Win, Wbr, Wout, 0, C.G == 256 ? MIXTR_IN : MIXTR_ALL);
    __syncthreads();
    LAS float* Wl = (LAS float*)C.lds;
    for (int idx = C.tid; idx < 16 * 1024; idx += NTHREADS) { const int k = idx >> 4, c = idx & 15; Wl[c * 1024 + k] = Win[(size_t)k * IN_DIM + 8448 + c]; }
    __syncthreads();
    norm_rows(C, gn, (bf16*)(C.ws + WS_XN), Wl, (float*)(C.ws + WS_BA));
    __syncthreads();
}

template <int S> __device__ __forceinline__ float dpp_shr(float old, float v) {
    return __builtin_bit_cast(float, __builtin_amdgcn_update_dpp(__builtin_bit_cast(int, old), __builtin_bit_cast(int, v), 0x110 + S, 0xf, 0xf, false));
}
__device__ __forceinline__ float pm1(float y) {
    const float p = y * (1.f + y * (0.5f + y * (1.f / 6.f + y * (1.f / 24.f + y * (1.f / 120.f + y * (1.f / 720.f + y * (1.f / 5040.f)))))));
    if (__builtin_expect(__any(fabsf(y) >= 0.35f), 0)) return fabsf(y) < 0.35f ? p : __expf(y) - 1.f;
    return p;
}
__device__ __forceinline__ bf16x8 pack8(const float* v) {
    v4u w; w.x = pk2(v[0], v[1]); w.y = pk2(v[2], v[3]); w.z = pk2(v[4], v[5]); w.w = pk2(v[6], v[7]); return __builtin_bit_cast(bf16x8, w);
}
__device__ __forceinline__ void unpack8(v4u w, float* v) {
    v[0] = bflo(w.x); v[1] = bfhi(w.x); v[2] = bflo(w.y); v[3] = bfhi(w.y); v[4] = bflo(w.z); v[5] = bfhi(w.z); v[6] = bflo(w.w); v[7] = bfhi(w.w);
}
constexpr size_t WS_RGS = WS_LSE + 512 * 1024;
__device__ __forceinline__ float swz_row15(float v) { return __builtin_bit_cast(float, __builtin_amdgcn_ds_swizzle(__builtin_bit_cast(int, v), 0x1F0)); }
template <int PASS> __device__ __forceinline__ void rg_item(const Ctx& C0, int l, int bl, int n, int half) {
    const Ctx C = relaunder(C0);
    const int lane = C.lane, wave = C.wave, fr = lane & 15, fq = lane >> 4;
    const size_t base = (size_t)bl * SEQ * 1024 + n * 64;
    const bf16* X = (const bf16*)(C.ws + WS_RGX) + base; const bf16* Gt = (const bf16*)(C.ws + WS_RGG) + base; bf16* YA = (bf16*)(C.ws + WS_YA) + base;
    float* RGS = (float*)(C.ws + WS_RGS) + (size_t)(bl * 16 + n) * 16 * 128;
    LAS float* ctab = (LAS float*)C.lds;
    LAS float* Wl = (LAS float*)(C.lds + 2048);
    LAS bf16x8* Afr = (LAS bf16x8*)(C.lds + 2048 + 32768);
    __syncthreads();
    {   const int t = C.tid;
        if (t < 64) { const int ch = n * 64 + t;
#pragma unroll
            for (int k = 0; k < 4; ++k) ctab[k * 64 + t] = INP(7)[(size_t)l * 4096 + k * 1024 + ch];
            ctab[4 * 64 + t] = INP(8)[l * 1024 + ch]; ctab[5 * 64 + t] = INP(10)[l * 1024 + ch]; ctab[6 * 64 + t] = INP(12)[l * 1024 + ch];
            ctab[7 * 64 + t] = fsoftplus(-INP(13)[l * 1024 + ch]); }
        const float* wr_ = INP(9) + (size_t)l * 65536 + n * 4096; const float* wi_ = INP(11) + (size_t)l * 65536 + n * 4096;
        for (int i = t; i < 4096; i += NTHREADS) { Wl[i] = wr_[i]; Wl[4096 + i] = wi_[i]; }
    }
    __syncthreads();
#pragma unroll
    for (int q2 = 0; q2 < 2; ++q2) {
        const int combo = wave * 2 + q2, gate_ = combo >> 3, mt = (combo >> 1) & 3, ks = combo & 1;
        const int d = (mt >> 1) * 32 + (fr >> 2) * 8 + (mt & 1) * 4 + (fr & 3); float a[8];
#pragma unroll
        for (int i = 0; i < 8; ++i) { const int c = ks * 32 + fq * 8 + i; a[i] = Wl[gate_ * 4096 + c * 64 + d]; }
        Afr[combo * 64 + lane] = pack8(a);
    }
    __syncthreads();
    const int seg = half * 8 + wave;
    float cA[16], cB[16];
#pragma unroll
    for (int i = 0; i < 16; ++i) { cA[i] = 1.f; cB[i] = 0.f; }
    if (PASS == 1) {
        for (int s2 = 0; s2 < seg; ++s2) {
            const f32x4* sp = (const f32x4*)(RGS + (s2 * 4 + fq) * 32);
#pragma unroll
            for (int i = 0; i < 8; ++i) { const f32x4 v = sp[i]; cB[2 * i] = v.x * cB[2 * i] + v.y; cB[2 * i + 1] = v.z * cB[2 * i + 1] + v.w; }
        }
    }
    v4u raw[2][4];
    {   const int t = seg * 128 + fr;
#pragma unroll
        for (int s_ = 0; s_ < 2; ++s_)
#pragma unroll
            for (int k = 0; k < 4; ++k) { const int tt = t - 3 + k; raw[s_][k] = (v4u){0u, 0u, 0u, 0u}; if (tt >= 0) raw[s_][k] = *(const v4u*)(X + (size_t)tt * 1024 + s_ * 32 + fq * 8); }
    }
#pragma unroll 1
    for (int tile = 0; tile < 8; ++tile) {
        asm volatile("" ::: "memory");
        const int t = seg * 128 + tile * 16 + fr;
        v4u cur[2][4];
#pragma unroll
        for (int s_ = 0; s_ < 2; ++s_)
#pragma unroll
            for (int k = 0; k < 4; ++k) cur[s_][k] = raw[s_][k];
        if (tile + 1 < 8) {
#pragma unroll
            for (int s_ = 0; s_ < 2; ++s_)
#pragma unroll
                for (int k = 0; k < 4; ++k) raw[s_][k] = *(const v4u*)(X + (size_t)(t + 16 - 3 + k) * 1024 + s_ * 32 + fq * 8);
        }
        v4u graw[2];
        if (PASS == 1) {
#pragma unroll
            for (int s_ = 0; s_ < 2; ++s_) graw[s_] = *(const v4u*)(Gt + (size_t)t * 1024 + s_ * 32 + fq * 8);
        }
        float xa[16];
#pragma unroll
        for (int s_ = 0; s_ < 2; ++s_) {
            const int ch0 = s_ * 32 + fq * 8; float acc8[8];
            { const f32x4 c0 = *(const LAS f32x4*)(ctab + 4 * 64 + ch0), c1 = *(const LAS f32x4*)(ctab + 4 * 64 + ch0 + 4);
              acc8[0] = c0.x; acc8[1] = c0.y; acc8[2] = c0.z; acc8[3] = c0.w; acc8[4] = c1.x; acc8[5] = c1.y; acc8[6] = c1.z; acc8[7] = c1.w; }
#pragma unroll
            for (int k = 0; k < 4; ++k) {
                float xv[8]; unpack8(cur[s_][k], xv);
                const f32x4 w0 = *(const LAS f32x4*)(ctab + k * 64 + ch0), w1 = *(const LAS f32x4*)(ctab + k * 64 + ch0 + 4);
                acc8[0] += w0.x * xv[0]; acc8[1] += w0.y * xv[1]; acc8[2] += w0.z * xv[2]; acc8[3] += w0.w * xv[3];
                acc8[4] += w1.x * xv[4]; acc8[5] += w1.y * xv[5]; acc8[6] += w1.z * xv[6]; acc8[7] += w1.w * xv[7];
            }
#pragma unroll
            for (int e = 0; e < 8; ++e) xa[s_ * 8 + e] = acc8[e];
        }
        bf16x8 Bop[2]; Bop[0] = pack8(xa); Bop[1] = pack8(xa + 8);
        f32x4 ar[4], ai[4];
#pragma unroll
        for (int mt = 0; mt < 4; ++mt) {
            ar[mt] = (f32x4){0.f, 0.f, 0.f, 0.f}; ai[mt] = (f32x4){0.f, 0.f, 0.f, 0.f};
#pragma unroll
            for (int ks = 0; ks < 2; ++ks) { ar[mt] = __builtin_amdgcn_mfma_f32_16x16x32_bf16(Afr[(mt * 2 + ks) * 64 + lane], Bop[ks], ar[mt], 0, 0, 0); ai[mt] = __builtin_amdgcn_mfma_f32_16x16x32_bf16(Afr[(8 + mt * 2 + ks) * 64 + lane], Bop[ks], ai[mt], 0, 0, 0); }
        }
        float gate[16], hout[16];
        if (PASS == 1) { unpack8(graw[0], gate); unpack8(graw[1], gate + 8); }
        f32x4 cbr[4], cbi[4], csp[4];
#pragma unroll
        for (int mt = 0; mt < 4; ++mt) { const int ch0 = (mt >> 1) * 32 + fq * 8 + (mt & 1) * 4;
            cbr[mt] = *(const LAS f32x4*)(ctab + 5 * 64 + ch0); cbi[mt] = *(const LAS f32x4*)(ctab + 6 * 64 + ch0); csp[mt] = *(const LAS f32x4*)(ctab + 7 * 64 + ch0); }
#pragma unroll
        for (int mt = 0; mt < 4; ++mt)
#pragma unroll
            for (int j = 0; j < 4; ++j) {
                const int ci = (mt >> 1) * 8 + (mt & 1) * 4 + j;
                const float r = fsigmoid(ar[mt][j] + cbr[mt][j]), ig = fsigmoid(ai[mt][j] + cbi[mt][j]);
                const float la = -8.f * r * csp[mt][j];
                const float p1 = pm1(la);
                float A = 1.f + p1; float B = __builtin_amdgcn_sqrtf(fmaxf(-p1 * (p1 + 2.f), 0.f)) * (ig * xa[ci]);
                { float Ap = dpp_shr<1>(1.f, A), Bp = dpp_shr<1>(0.f, B); B = A * Bp + B; A = A * Ap; }
                { float Ap = dpp_shr<2>(1.f, A), Bp = dpp_shr<2>(0.f, B); B = A * Bp + B; A = A * Ap; }
                { float Ap = dpp_shr<4>(1.f, A), Bp = dpp_shr<4>(0.f, B); B = A * Bp + B; A = A * Ap; }
                { float Ap = dpp_shr<8>(1.f, A), Bp = dpp_shr<8>(0.f, B); B = A * Bp + B; A = A * Ap; }
                if (PASS == 0) {
                    const float A15 = swz_row15(A), B15 = swz_row15(B);
                    cB[ci] = A15 * cB[ci] + B15; cA[ci] = A15 * cA[ci];
                } else {
                    const float h = B + A * cB[ci];
                    cB[ci] = swz_row15(h);
                    hout[ci] = h * gate[ci];
                }
            }
        if (PASS == 1) {
#pragma unroll
            for (int s_ = 0; s_ < 2; ++s_) *(bf16x8*)(YA + (size_t)t * 1024 + s_ * 32 + fq * 8) = pack8(hout + s_ * 8);
        }
    }
    if (PASS == 0 && fr == 0) {
        f32x4* sp = (f32x4*)(RGS + (seg * 4 + fq) * 32);
#pragma unroll
        for (int i = 0; i < 8; ++i) sp[i] = (f32x4){cA[2 * i], cB[2 * i], cA[2 * i + 1], cB[2 * i + 1]};
    }
}

__device__ __forceinline__ void attn_item(const Ctx& C0, int l, int bl, int h, int blk) {
    const Ctx C = relaunder(C0);
    const int lane = C.lane, wave = C.wave, fr = lane & 15, fq = lane >> 4, tid = C.tid;
    const int g = h >> 2, dil = g == 0 ? 1 : (g == 1 ? 4 : 16);
    const int r = g == 0 ? 0 : (g == 1 ? (blk >> 2) : blk), nb = g == 0 ? blk : (g == 1 ? (blk & 3) : 0);
    const bf16* Q = (const bf16*)(C.ws + WS_AQ) + (size_t)bl * SEQ * ATT_W + h * 64;
    const bf16* K = (const bf16*)(C.ws + WS_AK) + (size_t)bl * SEQ * ATT_W + h * 64;
    const bf16* V = (const bf16*)(C.ws + WS_AV) + (size_t)bl * SEQ * ATT_W + h * 64;
    bf16* O = (bf16*)(C.ws + WS_YB) + (size_t)bl * SEQ * ATT_W + h * 64;
    float* LSE = (float*)(C.ws + WS_LSE) + (size_t)bl * SEQ * 12 + h;
    LAS bf16* VT = (LAS bf16*)C.lds;
    LAS bf16* Pw = (LAS bf16*)(C.lds + 64 * 264 * 2) + wave * (16 * 168);
    const float slope = exp2f(-8.f * (float)(h + 1) / 12.f) * (float)dil;
    __syncthreads();
    {
        const int key = tid & 255, half = tid >> 8; int lsub = (nb - 1) * 128 + key; if (lsub < 0) lsub = 0;
        const size_t t = (size_t)lsub * dil + r;
#pragma unroll
        for (int c = 0; c < 4; ++c) { const v4u raw = *(const v4u*)(V + t * ATT_W + half * 32 + c * 8); const int d0 = half * 32 + c * 8;
            VT[(d0 + 0) * 264 + key] = (bf16)(raw.x & 0xffff); VT[(d0 + 1) * 264 + key] = (bf16)(raw.x >> 16); VT[(d0 + 2) * 264 + key] = (bf16)(raw.y & 0xffff); VT[(d0 + 3) * 264 + key] = (bf16)(raw.y >> 16);
            VT[(d0 + 4) * 264 + key] = (bf16)(raw.z & 0xffff); VT[(d0 + 5) * 264 + key] = (bf16)(raw.z >> 16); VT[(d0 + 6) * 264 + key] = (bf16)(raw.w & 0xffff); VT[(d0 + 7) * 264 + key] = (bf16)(raw.w >> 16); }
        if (tid < 64) { for (int c = 256; c < 264; ++c) VT[tid * 264 + c] = 0; }
    }
    bf16x8 Aq[2];
    {   const size_t t = (size_t)(nb * 128 + wave * 16 + fr) * dil + r; float v[16]; float ss = 0.f;
#pragma unroll
        for (int ks = 0; ks < 2; ++ks) { const v4u raw = *(const v4u*)(Q + t * ATT_W + ks * 32 + fq * 8); unpack8(raw, v + ks * 8); }
#pragma unroll
        for (int i = 0; i < 16; ++i) ss += v[i] * v[i];
        ss += __shfl_xor(ss, 16); ss += __shfl_xor(ss, 32);
        const float rs = rsqrtf(ss * (1.f / 64.f) + EPS) * 0.125f;
#pragma unroll
        for (int ks = 0; ks < 2; ++ks) {
#pragma unroll
            for (int i = 0; i < 8; ++i) v[ks * 8 + i] *= rs * INP(14)[l * 768 + h * 64 + ks * 32 + fq * 8 + i];
            Aq[ks] = pack8(v + ks * 8); }
    }
    float gk[16];
#pragma unroll
    for (int ks = 0; ks < 2; ++ks)
#pragma unroll
        for (int i = 0; i < 8; ++i) gk[ks * 8 + i] = INP(15)[l * 768 + h * 64 + ks * 32 + fq * 8 + i];
    f32x4 sacc[9]; float mx[4];
#pragma unroll
    for (int j = 0; j < 4; ++j) mx[j] = -1e30f;
#pragma unroll
    for (int kk = 0; kk < 9; ++kk) {
        const int kt = wave + kk; int kj = kt * 16 + fr; int lsub = (nb - 1) * 128 + kj; if (lsub < 0) lsub = 0;
        const size_t t = (size_t)lsub * dil + r; float v[16]; float ss = 0.f;
#pragma unroll
        for (int ks = 0; ks < 2; ++ks) { const v4u raw = *(const v4u*)(K + t * ATT_W + ks * 32 + fq * 8); unpack8(raw, v + ks * 8); }
#pragma unroll
        for (int i = 0; i < 16; ++i) ss += v[i] * v[i];
        ss += __shfl_xor(ss, 16); ss += __shfl_xor(ss, 32);
        const float rs = rsqrtf(ss * (1.f / 64.f) + EPS);
#pragma unroll
        for (int i = 0; i < 16; ++i) v[i] *= rs * gk[i];
        f32x4 s = (f32x4){0.f, 0.f, 0.f, 0.f};
        s = __builtin_amdgcn_mfma_f32_16x16x32_bf16(Aq[0], pack8(v), s, 0, 0, 0);
        s = __builtin_amdgcn_mfma_f32_16x16x32_bf16(Aq[1], pack8(v + 8), s, 0, 0, 0);
#pragma unroll
        for (int j = 0; j < 4; ++j) {
            const int delta = wave * 16 + fq * 4 + j + 128 - kj;
            const bool valid = delta >= 0 && delta <= 128 && (nb > 0 || kj >= 128);
            s[j] = valid ? s[j] - slope * (float)delta : -1e30f;
            mx[j] = fmaxf(mx[j], s[j]);
        }
        sacc[kk] = s;
    }
    float den[4];
#pragma unroll
    for (int j = 0; j < 4; ++j) { mx[j] = row16_max(mx[j]); den[j] = 0.f; }
#pragma unroll
    for (int kk = 0; kk < 9; ++kk)
#pragma unroll
        for (int j = 0; j < 4; ++j) { const float p = __expf(sacc[kk][j] - mx[j]); den[j] += p; Pw[(fq * 4 + j) * 168 + kk * 16 + fr] = (bf16)f2bf(p); }
    if (fr < 8) {
#pragma unroll
        for (int j = 0; j < 4; ++j) { Pw[(fq * 4 + j) * 168 + 144 + fr] = 0; Pw[(fq * 4 + j) * 168 + 152 + fr] = 0; }
    }
#pragma unroll
    for (int j = 0; j < 4; ++j) { den[j] = row16_sum(den[j]); }
    __syncthreads();
    f32x4 oacc[4];
#pragma unroll
    for (int nt = 0; nt < 4; ++nt) oacc[nt] = (f32x4){0.f, 0.f, 0.f, 0.f};
#pragma unroll
    for (int ks = 0; ks < 5; ++ks) {
        const bf16x8 pa = *(const LAS bf16x8*)(Pw + fr * 168 + ks * 32 + fq * 8);
        int kb = wave * 16 + ks * 32 + fq * 8; if (kb > 256) kb = 256;
#pragma unroll
        for (int nt = 0; nt < 4; ++nt) { const bf16x8 vb = *(const LAS bf16x8*)(VT + (nt * 16 + fr) * 264 + kb); oacc[nt] = __builtin_amdgcn_mfma_f32_16x16x32_bf16(pa, vb, oacc[nt], 0, 0, 0); }
    }
#pragma unroll
    for (int j = 0; j < 4; ++j) {
        const size_t t = (size_t)(nb * 128 + wave * 16 + fq * 4 + j) * dil + r; const float inv = 1.f / den[j];
#pragma unroll
        for (int nt = 0; nt < 4; ++nt) O[t * ATT_W + nt * 16 + fr] = (bf16)f2bf(oacc[nt][j] * inv);
        if (fr == 0) LSE[t * 12] = mx[j] + __logf(den[j]);
    }
}
__device__ __forceinline__ void attn_fix(const Ctx& C, int bx, int first_block, int nblocks) {
    const bf16* dummy = nullptr; (void)dummy;
    bf16* Y = (bf16*)(C.ws + WS_YB); const float* LSE = (const float*)(C.ws + WS_LSE);
    const size_t total = (size_t)MS * 96, stride = (size_t)nblocks * NTHREADS;
    for (size_t i = (size_t)(bx - first_block) * NTHREADS + C.tid; i < total; i += stride) {
        const size_t row = i / 96; const int c = (int)(i % 96), head = c >> 3, g = head >> 2, j = head & 3;
        const float l0 = LSE[row * 12 + j], l1 = LSE[row * 12 + 4 + j], l2 = LSE[row * 12 + 8 + j];
        const float m = fmaxf(l0, fmaxf(l1, l2)); const float e0 = __expf(l0 - m), e1 = __expf(l1 - m), e2 = __expf(l2 - m);
        const float w = (g == 0 ? e0 : (g == 1 ? e1 : e2)) / (e0 + e1 + e2);
        v4u* p = (v4u*)(Y + row * ATT_W + c * 8); const v4u raw = *p; float v[8]; unpack8(raw, v);
#pragma unroll
        for (int e = 0; e < 8; ++e) v[e] *= w;
        *p = __builtin_bit_cast(v4u, pack8(v));
    }
}

constexpr int DL_KH = 0, DL_QH = 17408, DL_VB = 34816, DL_KB = 52480, DL_KD = 70144, DL_XRM = 87808, DL_PT = 97024, DL_PRM = 106240, DL_SET2 = 27648, DL_TAB = 115456 + 27648, DL_RS = 138;
__device__ __forceinline__ int permc(int c) { return (c & 32) + ((c & 15) >> 2) * 8 + ((c >> 4) & 1) * 4 + (c & 3); }
#define MFMA16(a, b, c) __builtin_amdgcn_mfma_f32_16x16x32_bf16(a, b, c, 0, 0, 0)
__device__ __forceinline__ void st_wt8(void* p, unsigned lo, unsigned hi) { __hip_atomic_store((GAS unsigned long long*)p, ((unsigned long long)hi << 32) | lo, __ATOMIC_RELAXED, __HIP_MEMORY_SCOPE_AGENT); }
__device__ __forceinline__ void st_wt2(void* p, unsigned v) { __hip_atomic_store((GAS unsigned short*)p, (unsigned short)v, __ATOMIC_RELAXED, __HIP_MEMORY_SCOPE_AGENT); }
__device__ __forceinline__ void dn_local_item(const Ctx& C0, int l, int s, int bl, int h, int chunk) {
    const Ctx C = relaunder(C0);
    const int lane = C.lane, wave = C.wave, fr = lane & 15, fq = lane >> 4, tid = C.tid;
    LAS bf16* Kh = (LAS bf16*)(C.lds + DL_KH); LAS bf16* Qh = (LAS bf16*)(C.lds + DL_QH); LAS bf16* Vb = (LAS bf16*)(C.lds + DL_VB); LAS bf16* Kb = (LAS bf16*)(C.lds + DL_KB);
    LAS bf16* Kd = (LAS bf16*)(C.lds + DL_KD); LAS bf16* Xrm = (LAS bf16*)(C.lds + DL_XRM); LAS bf16* PT = (LAS bf16*)(C.lds + DL_PT); LAS bf16* Prm = (LAS bf16*)(C.lds + DL_PRM);
    LAS float* gamT = (LAS float*)(C.lds + DL_TAB); LAS float* betT = gamT + 64;
    const int item = (bl * 8 + h) * 32 + chunk;
    const size_t rl0 = (size_t)bl * SEQ + chunk * 64;
    const size_t rg0 = (size_t)s * MS + rl0;
    float* U0T = (float*)(C.ws + WS_U0T) + (size_t)item * 8192; bf16* WK = (bf16*)(C.ws + WS_WK) + (size_t)item * 8192; bf16* QD = (bf16*)(C.ws + WS_QD) + (size_t)item * 8192;
    bf16* KDT = (bf16*)(C.ws + WS_KDT) + (size_t)item * 8192; bf16* QK = (bf16*)(C.ws + WS_QK) + (size_t)item * 4096;
    __syncthreads();
    float gam_last;
    {   const float* ba = (const float*)(C.ws + WS_BA) + (rg0 + lane) * 16;
        const float beta = fsigmoid(ba[h]);
        const float gl = -expf(INP(17)[l * 8 + h]) * fsoftplus(ba[8 + h] + INP(18)[l * 8 + h]);
        float gm = gl;
#pragma unroll
        for (int o = 1; o < 64; o <<= 1) { const float t = __shfl_up(gm, o); if (lane >= o) gm += t; }
        gamT[lane] = gm; betT[lane] = beta; gam_last = __shfl(gm, 63);
        LDS_WAIT();
    }
    {   const int rp = fq, cg = fr;
        const int tc0 = chunk * 64 + wave * 8 + rp * 2;
#pragma unroll
        for (int sec = 0; sec < 3; ++sec) {
            const bf16* src = (const bf16*)(C.ws + (sec == 0 ? WS_DQ : (sec == 1 ? WS_DK : WS_DV))) + h * 128 + cg * 8;
            v4u rawr[5];
#pragma unroll
            for (int k = 0; k < 5; ++k) { const int tt = tc0 - 3 + k; rawr[k] = (v4u){0u, 0u, 0u, 0u}; if (tt >= 0) rawr[k] = *(const v4u*)(src + ((size_t)bl * SEQ + tt) * 1024); }
            float w[4][8];
#pragma unroll
            for (int k = 0; k < 4; ++k) { const f32x4* wp = (const f32x4*)(INP(16) + (size_t)l * 12288 + k * 3072 + sec * 1024 + h * 128 + cg * 8); const f32x4 a = wp[0], b = wp[1];
                w[k][0] = a.x; w[k][1] = a.y; w[k][2] = a.z; w[k][3] = a.w; w[k][4] = b.x; w[k][5] = b.y; w[k][6] = b.z; w[k][7] = b.w; }
#pragma unroll
            for (int rr = 0; rr < 2; ++rr) {
                const int r = wave * 8 + rp * 2 + rr;
                float xw[4][8];
#pragma unroll
                for (int k = 0; k < 4; ++k) unpack8(rawr[rr + k], xw[k]);
                float val[8]; float ss = 0.f;
#pragma unroll
                for (int e = 0; e < 8; ++e) { const float a = w[0][e] * xw[0][e] + w[1][e] * xw[1][e] + w[2][e] * xw[2][e] + w[3][e] * xw[3][e]; val[e] = fsilu(a); ss += val[e] * val[e]; }
                ss = row16_sum(ss);
                const float rn = rsqrtf(ss + EPS), gm = gamT[r], bt = betT[r];
                if (sec == 0) {
                    float qh[8], qd[8]; const float eg = __expf(gm);
#pragma unroll
                    for (int e = 0; e < 8; ++e) { qh[e] = val[e] * rn * 0.08838834764831845f; qd[e] = qh[e] * eg; }
                    *(LAS bf16x8*)(Qh + r * 136 + cg * 8) = pack8(qh);
                    const int c0 = cg * 8, p0 = (c0 & ~31) + ((c0 & 15) >> 2) * 8 + ((c0 >> 4) & 1) * 4;
                    v2u a; a.x = pk2(qd[0], qd[1]); a.y = pk2(qd[2], qd[3]); v2u b; b.x = pk2(qd[4], qd[5]); b.y = pk2(qd[6], qd[7]);
                    { const int fi = ((r >> 4) * 4 + (p0 >> 5)) * 64 + ((p0 & 31) >> 3) * 16 + (r & 15);
                      *(v2u*)(QD + fi * 8 + (p0 & 7)) = a; *(v2u*)(QD + (fi + 16) * 8 + (p0 & 7)) = b; }
                } else if (sec == 1) {
                    float kh[8]; const float eb = bt * __expf(gm), ed = __expf(gam_last - gm);
#pragma unroll
                    for (int e = 0; e < 8; ++e) kh[e] = val[e] * rn;
                    *(LAS bf16x8*)(Kh + r * 136 + cg * 8) = pack8(kh);
                    LAS unsigned* pb = (LAS unsigned*)(Kb + r * DL_RS + cg * 8); LAS unsigned* pd = (LAS unsigned*)(Kd + r * DL_RS + cg * 8);
#pragma unroll
                    for (int e = 0; e < 4; ++e) { pb[e] = pk2(kh[2 * e] * eb, kh[2 * e + 1] * eb); pd[e] = pk2(kh[2 * e] * ed, kh[2 * e + 1] * ed); }
                } else {
                    LAS unsigned* pv = (LAS unsigned*)(Vb + r * DL_RS + cg * 8);
#pragma unroll
                    for (int e = 0; e < 4; ++e) pv[e] = pk2(val[2 * e] * bt, val[2 * e + 1] * bt);
                }
            }
        }
    }
    __syncthreads();
    f32x4 Xacc[2];
#pragma unroll
    for (int q = 0; q < 2; ++q) {
        const int p = wave + 8 * q, mt = p >> 2, nt = p & 3;
        f32x4 kk = (f32x4){0.f, 0.f, 0.f, 0.f}, qq = (f32x4){0.f, 0.f, 0.f, 0.f};
        if (nt <= mt) {
#pragma unroll
            for (int ks = 0; ks < 4; ++ks) {
                const bf16x8 a = *(const LAS bf16x8*)(Kh + (mt * 16 + fr) * 136 + ks * 32 + fq * 8), aq = *(const LAS bf16x8*)(Qh + (mt * 16 + fr) * 136 + ks * 32 + fq * 8);
                const bf16x8 b = *(const LAS bf16x8*)(Kh + (nt * 16 + fr) * 136 + ks * 32 + fq * 8);
                kk = MFMA16(a, b, kk); qq = MFMA16(aq, b, qq);
            }
        }
        const int jj = nt * 16 + fr; const float gj = gamT[jj];
        f32x4 xa;
#pragma unroll
        for (int j = 0; j < 4; ++j) {
            const int i = mt * 16 + fq * 4 + j; const float dec = (jj <= i) ? __expf(gamT[i] - gj) : 0.f;
            const float Aij = (jj < i) ? betT[i] * kk[j] * dec : 0.f; const float qk = (jj <= i) ? qq[j] * dec : 0.f;
            xa[j] = (i == jj ? 1.f : 0.f) - Aij;
            Xrm[i * 72 + jj] = (bf16)f2bf(xa[j]); Prm[i * 72 + jj] = (bf16)f2bf(Aij); PT[jj * 72 + i] = (bf16)f2bf(Aij);
            { const int pj = permc(jj); QK[(((i >> 4) * 2 + (pj >> 5)) * 64 + ((pj & 31) >> 3) * 16 + (i & 15)) * 8 + (pj & 7)] = (bf16)f2bf(qk); }
        }
        Xacc[q] = xa;
    }
    __syncthreads();
#pragma unroll
    for (int q = 0; q < 2; ++q) {
        const int p = wave + 8 * q, mt = p >> 2, nt = p & 3;
        if (nt > mt) {
            const int jj = nt * 16 + fr;
#pragma unroll
            for (int j = 0; j < 4; ++j) { const int i = mt * 16 + fq * 4 + j; (Xrm + DL_SET2 / 2)[i * 72 + jj] = 0; (Prm + DL_SET2 / 2)[i * 72 + jj] = 0; (PT + DL_SET2 / 2)[jj * 72 + i] = 0; }
        }
    }
#pragma unroll 1
    for (int st = 0; st < 6; ++st) {
        LAS bf16* Xr = Xrm + (st & 1) * (DL_SET2 / 2); LAS bf16* Pr = Prm + (st & 1) * (DL_SET2 / 2); LAS bf16* Pt = PT + (st & 1) * (DL_SET2 / 2);
        LAS bf16* Xw = Xrm + ((st + 1) & 1) * (DL_SET2 / 2); LAS bf16* Pw_ = Prm + ((st + 1) & 1) * (DL_SET2 / 2); LAS bf16* Ptw = PT + ((st + 1) & 1) * (DL_SET2 / 2);
#pragma unroll
        for (int q = 0; q < 2; ++q) {
            const int p = wave + 8 * q, mt = p >> 2, nt = p & 3;
            if (nt <= mt) {
                f32x4 Pn = (f32x4){0.f, 0.f, 0.f, 0.f};
#pragma unroll
                for (int ks = 0; ks < 2; ++ks) {
                    const bf16x8 b = *(const LAS bf16x8*)(Pt + (nt * 16 + fr) * 72 + ks * 32 + fq * 8);
                    if (st < 5) { const bf16x8 a = *(const LAS bf16x8*)(Pr + (mt * 16 + fr) * 72 + ks * 32 + fq * 8); Pn = MFMA16(a, b, Pn); }
                    if (st > 0) { const bf16x8 ax = *(const LAS bf16x8*)(Xr + (mt * 16 + fr) * 72 + ks * 32 + fq * 8); Xacc[q] = MFMA16(ax, b, Xacc[q]); }
                }
                const int jj = nt * 16 + fr;
#pragma unroll
                for (int j = 0; j < 4; ++j) { const int i = mt * 16 + fq * 4 + j;
                    Xw[i * 72 + jj] = (bf16)f2bf(Xacc[q][j]);
                    if (st < 5) { Pw_[i * 72 + jj] = (bf16)f2bf(Pn[j]); Ptw[jj * 72 + i] = (bf16)f2bf(Pn[j]); } }
            }
        }
        __syncthreads();
    }
    {
        bf16x8 ta[4][2];
#pragma unroll
        for (int mt = 0; mt < 4; ++mt)
#pragma unroll
            for (int ks = 0; ks < 2; ++ks) ta[mt][ks] = *(const LAS bf16x8*)(Xrm + (mt * 16 + fr) * 72 + ks * 32 + fq * 8);
        bf16x8 vb0, vb1, kb0, kb1;
#pragma unroll
        for (int i = 0; i < 8; ++i) { const int c0_ = (fq * 8 + i) * DL_RS + wave * 16 + fr, c1_ = c0_ + 32 * DL_RS;
            vb0[i] = (short)Vb[c0_]; vb1[i] = (short)Vb[c1_]; kb0[i] = (short)Kb[c0_]; kb1[i] = (short)Kb[c1_]; }
#pragma unroll
        for (int mt = 0; mt < 4; ++mt) {
            f32x4 u = (f32x4){0.f, 0.f, 0.f, 0.f}; u = MFMA16(ta[mt][0], vb0, u); u = MFMA16(ta[mt][1], vb1, u);
            *(f32x4*)(U0T + (wave * 16 + fr) * 64 + mt * 16 + fq * 4) = u;
            f32x4 wv = (f32x4){0.f, 0.f, 0.f, 0.f}; wv = MFMA16(kb0, ta[mt][0], wv); wv = MFMA16(kb1, ta[mt][1], wv);
            v2u o; o.x = pk2(wv[0], wv[1]); o.y = pk2(wv[2], wv[3]);
            *(v2u*)(WK + ((mt * 4 + (wave >> 1)) * 64 + lane) * 8 + (wave & 1) * 4) = o;
        }
    }
    {   v4u* dp = (v4u*)KDT;
#pragma unroll
        for (int q2 = 0; q2 < 2; ++q2) {
            const int j = tid + 512 * q2, f = j >> 6, lf = j & 63, dk_ = (f >> 1) * 16 + (lf & 15), cb = (f & 1) * 32 + (lf >> 4) * 4;
            bf16x8 w;
#pragma unroll
            for (int i = 0; i < 8; ++i) w[i] = (short)Kd[(cb + (i >> 2) * 16 + (i & 3)) * DL_RS + dk_];
            dp[j] = __builtin_bit_cast(v4u, w);
        }
    }
}

__device__ __forceinline__ bf16x8 pack_acc2(const f32x4 a, const f32x4 b) { v4u w; w.x = pk2(a[0], a[1]); w.y = pk2(a[2], a[3]); w.z = pk2(b[0], b[1]); w.w = pk2(b[2], b[3]); return __builtin_bit_cast(bf16x8, w); }
__device__ __forceinline__ void wait_flag(unsigned* f, unsigned seen) {
    unsigned sp = 0;
    while (seen == 0u) { __builtin_amdgcn_s_sleep(2); seen = __hip_atomic_load(f, __ATOMIC_RELAXED, __HIP_MEMORY_SCOPE_AGENT); if (++sp > (1u << 22)) break; }
    __builtin_amdgcn_fence(__ATOMIC_ACQUIRE, "agent");
}
__device__ __forceinline__ void dn_seq_chain(const Ctx& C0, int l, int s, int bl, int h, int half) {
    const Ctx C = relaunder(C0);
    const int lane = C.lane, wave = C.wave, fr = lane & 15, fq = lane >> 4;
    constexpr int SQ_BUF = 57344;
    const bool active = wave < 4;
    const int colw = half * 64 + (wave & 3) * 16;
    f32x4 Sacc[8];
#pragma unroll
    for (int mt = 0; mt < 8; ++mt) Sacc[mt] = (f32x4){0.f, 0.f, 0.f, 0.f};
    const float nA = -expf(INP(17)[l * 8 + h]), dtb = INP(18)[l * 8 + h];
    const int item0 = (bl * 8 + h) * 32; const size_t rlb = (size_t)bl * SEQ, rgb = (size_t)s * MS + rlb;
    const unsigned char* gWK = C.ws + WS_WK + (size_t)item0 * 16384; const unsigned char* gQD = C.ws + WS_QD + (size_t)item0 * 16384;
    const unsigned char* gKD = C.ws + WS_KDT + (size_t)item0 * 16384; const unsigned char* gQK = C.ws + WS_QK + (size_t)item0 * 8192;
    const float* gU0 = (const float*)(C.ws + WS_U0T) + (size_t)item0 * 8192 + colw * 64; const int lo_u0 = fr * 64 + fq * 4;
    bf16* gYC = (bf16*)(C.ws + WS_YC_OF(s)) + rlb * 1024 + h * 128 + colw; const int lo_row = fq * 4 * 1024 + fr;
    const float* gBA = (const float*)(C.ws + WS_BA) + (rgb + lane) * 16 + 8 + h;
    const int lo16 = lane * 16;
#define SQ_DMA(chunk_, buf_) do { _Pragma("unroll") for (int i_ = 0; i_ < 14; ++i_) { const int a_ = i_ >> 2; const int so_ = ((wave - 4) + 4 * (i_ & 3)) * 1024; \
        const unsigned char* gp = (a_ == 0 ? gWK : (a_ == 1 ? gQD : (a_ == 2 ? gKD : gQK))) + (size_t)(chunk_) * (a_ == 3 ? 8192 : 16384) + so_; \
        __builtin_amdgcn_global_load_lds((const unsigned*)(gp + lo16), (LAS unsigned*)(C.lds + (buf_) * SQ_BUF + a_ * 16384 + so_), 16, 0, 0); } } while (0)
    LAS float* cd = (LAS float*)(C.lds + 2 * SQ_BUF);
    __syncthreads();
    f32x4 u0r[4]; float ban = 0.f;
    unsigned ypend[8];
#pragma unroll
    for (int i = 0; i < 8; ++i) ypend[i] = 0u;
#pragma unroll
    for (int mt = 0; mt < 4; ++mt) u0r[mt] = (f32x4){0.f, 0.f, 0.f, 0.f};
    if (active) {
#pragma unroll
        for (int mt = 0; mt < 4; ++mt) u0r[mt] = *(const f32x4*)((gU0 + mt * 16) + lo_u0);
    } else {
        SQ_DMA(0, 0);
        if (wave == 4) { const float c0_ = __expf(wave_sum(nA * fsoftplus(gBA[0] + dtb))); if (lane == 0) cd[0] = c0_; ban = gBA[(size_t)64 * 16]; }
    }
    asm volatile("s_waitcnt vmcnt(0)" ::: "memory");
#pragma unroll 1
    for (int chunk = 0; chunk < 32; ++chunk) {
        if (!active) asm volatile("s_waitcnt vmcnt(0) lgkmcnt(0)" ::: "memory");
        else asm volatile("s_waitcnt lgkmcnt(0)" ::: "memory");
        __builtin_amdgcn_s_barrier();
        asm volatile("" ::: "memory");
        const bool more = chunk + 1 < 32;
        if (!active && more) {
            SQ_DMA(chunk + 1, (chunk + 1) & 1);
            if (wave == 4) { const float c1_ = __expf(wave_sum(nA * fsoftplus(ban + dtb))); if (lane == 0) cd[(chunk + 1) & 1] = c1_; if (chunk + 2 < 32) ban = gBA[(size_t)(chunk + 2) * 64 * 16]; }
        }
        if (active) {
            __builtin_amdgcn_s_setprio(3);
            const float cdec = cd[chunk & 1];
            const LAS unsigned char* B = C.lds + (chunk & 1) * SQ_BUF + lane * 16;
            bf16x8 Bs[4];
#pragma unroll
            for (int ks = 0; ks < 4; ++ks) Bs[ks] = pack_acc2(Sacc[2 * ks], Sacc[2 * ks + 1]);
            f32x4 u[4], o[4];
#pragma unroll
            for (int mt = 0; mt < 4; ++mt) {
                bf16x8 fa[4], fq_[4];
#pragma unroll
                for (int ks = 0; ks < 4; ++ks) { fa[ks] = *(const LAS bf16x8*)(B + (mt * 4 + ks) * 1024); fq_[ks] = *(const LAS bf16x8*)(B + 16384 + (mt * 4 + ks) * 1024); }
                f32x4 t = (f32x4){0.f, 0.f, 0.f, 0.f}; o[mt] = (f32x4){0.f, 0.f, 0.f, 0.f};
#pragma unroll
                for (int ks = 0; ks < 4; ++ks) { t = MFMA16(fa[ks], Bs[ks], t); o[mt] = MFMA16(fq_[ks], Bs[ks], o[mt]); }
                u[mt] = u0r[mt] - t;
            }
            if (more) {
#pragma unroll
                for (int mt = 0; mt < 4; ++mt) u0r[mt] = *(const f32x4*)((gU0 + (size_t)(chunk + 1) * 8192 + mt * 16) + lo_u0);
            }
            if (chunk > 0) {
#pragma unroll
                for (int i = 0; i < 16; ++i) (gYC + (size_t)((chunk - 1) * 64 + (i >> 2) * 16 + (i & 3)) * 1024)[lo_row] = (bf16)((i & 1) ? (ypend[i >> 1] >> 16) : (ypend[i >> 1] & 0xffffu));
            }
            bf16x8 Bu[2]; Bu[0] = pack_acc2(u[0], u[1]); Bu[1] = pack_acc2(u[2], u[3]);
            bf16x8 fk[8];
#pragma unroll
            for (int i = 0; i < 8; ++i) fk[i] = *(const LAS bf16x8*)(B + 49152 + i * 1024);
#pragma unroll
            for (int mt = 0; mt < 8; ++mt) Sacc[mt] = Sacc[mt] * cdec;
#pragma unroll
            for (int mt = 0; mt < 4; ++mt)
#pragma unroll
                for (int ks = 0; ks < 2; ++ks) o[mt] = MFMA16(fk[mt * 2 + ks], Bu[ks], o[mt]);
#pragma unroll
            for (int hh = 0; hh < 2; ++hh) {
#pragma unroll
                for (int i = 0; i < 8; ++i) fk[i] = *(const LAS bf16x8*)(B + 32768 + (hh * 8 + i) * 1024);
#pragma unroll
                for (int m4 = 0; m4 < 4; ++m4)
#pragma unroll
                    for (int ks = 0; ks < 2; ++ks) Sacc[hh * 4 + m4] = MFMA16(fk[m4 * 2 + ks], Bu[ks], Sacc[hh * 4 + m4]);
            }
#pragma unroll
            for (int mt = 0; mt < 4; ++mt) { ypend[mt * 2] = pk2(o[mt][0], o[mt][1]); ypend[mt * 2 + 1] = pk2(o[mt][2], o[mt][3]); }
            __builtin_amdgcn_s_setprio(0);
        }
    }
    if (active) {
#pragma unroll
        for (int i = 0; i < 16; ++i) (gYC + (size_t)(31 * 64 + (i >> 2) * 16 + (i & 3)) * 1024)[lo_row] = (bf16)((i & 1) ? (ypend[i >> 1] >> 16) : (ypend[i >> 1] & 0xffffu));
    }
#undef SQ_DMA
}
__device__ __forceinline__ void yc_finalize(const Ctx& C, int l, int s) {
    bf16* YC = (bf16*)(C.ws + WS_YC_OF(s)); const bf16* DZ = (const bf16*)(C.ws + WS_DZ);
    float gain[16];
#pragma unroll
    for (int q = 0; q < 4; ++q) { const f32x4 g = *(const f32x4*)(INP(19) + l * 1024 + C.lane * 16 + q * 4); gain[q * 4] = g.x; gain[q * 4 + 1] = g.y; gain[q * 4 + 2] = g.z; gain[q * 4 + 3] = g.w; }
    for (int m = C.gw; m < MS; m += C.NGW) {
        v4u* yp = (v4u*)(YC + (size_t)m * 1024 + C.lane * 16); const v4u* zp = (const v4u*)(DZ + (size_t)m * 1024 + C.lane * 16);
        const v4u a0 = yp[0], a1 = yp[1], z0 = zp[0], z1 = zp[1];
        float o[16], z[16]; unpack8(a0, o); unpack8(a1, o + 8); unpack8(z0, z); unpack8(z1, z + 8);
        float ss = 0.f;
#pragma unroll
        for (int e = 0; e < 16; ++e) ss += o[e] * o[e];
        ss += __shfl_xor(ss, 1); ss += __shfl_xor(ss, 2); ss += __shfl_xor(ss, 4);
        const float rn = rsqrtf(ss * (1.f / 128.f) + EPS);
#pragma unroll
        for (int e = 0; e < 16; ++e) o[e] = o[e] * rn * gain[e] * z[e];
        yp[0] = __builtin_bit_cast(v4u, pack8(o)); yp[1] = __builtin_bit_cast(v4u, pack8(o + 8));
    }
}

constexpr int PH_PER_LAYER = 8 + 6 * NSPLIT, N_PHASES = DEPTH * PH_PER_LAYER;
struct Args { const float* in[26]; float* out; unsigned char* ws; int ph_lo, ph_hi; };
constexpr int N_RG = BS * 16 * 2, N_DN = BS * 8 * 32, N_AT = BS * 12 * 16, N_ITEMS = N_RG + N_DN + N_AT;

__global__ void __launch_bounds__(NTHREADS, 2) fwd_kernel(Args args) {
    extern __shared__ __attribute__((aligned(16))) unsigned char lds_raw[];
    cg::grid_group grid = cg::this_grid();
    Ctx C;
    C.lds = (LAS unsigned char*)lds_raw; C.ldsg = lds_raw;
    C.tid = threadIdx.x; C.lane = C.tid & 63; C.wave = __builtin_amdgcn_readfirstlane(C.tid >> 6);
    C.G = gridDim.x; C.gw = blockIdx.x * NWAVES + C.wave; C.NGW = C.G * NWAVES;
    C.ws = args.ws; C.x = args.out;
    if (C.tid < 26) *(LAS unsigned long long*)(C.lds + PTAB_OFF + 8 * C.tid) = (unsigned long long)args.in[C.tid];
    __syncthreads();
    LAS int* slot = (LAS int*)(C.lds + LDS_BYTES - 64);
    int bx = blockIdx.x;

#pragma unroll 1
    for (int ph = args.ph_lo; ph < args.ph_hi; ++ph) {
        const int l = ph / PH_PER_LAYER, q = ph % PH_PER_LAYER;
#ifndef PROBE_MASK
#define PROBE_MASK 0
#endif
        int nrep = 1;
        if (PROBE_MASK) {
            const int sq_ = (q >= 4 && q < 4 + 6 * NSPLIT) ? (q - 4) % 6 : -1;
            if ((PROBE_MASK & 1) && (q == 0 || q == 3 || q == PH_PER_LAYER - 3)) nrep = 2;
            if ((PROBE_MASK & 2) && (q == 1 || q == PH_PER_LAYER - 2)) nrep = 2;
            if ((PROBE_MASK & 4) && sq_ == 0) nrep = 2;
            if ((PROBE_MASK & 8) && sq_ == 1) nrep = 2;
            if ((PROBE_MASK & 16) && sq_ == 2) nrep = 2;

            if ((PROBE_MASK & 32) && sq_ == 4) nrep = 2;
        }
#pragma unroll 1
        for (int rep = 0; rep < nrep; ++rep) {
        if (rep) grid.sync();
        { unsigned long long w_ = (unsigned long long)args.ws, x_ = (unsigned long long)args.out; int g_ = gridDim.x, b_ = blockIdx.x, t_ = threadIdx.x; asm volatile("" : "+s"(w_), "+s"(x_), "+s"(g_), "+s"(b_), "+v"(t_)); C.ws = (unsigned char*)(GAS unsigned char*)w_; C.x = (float*)(GAS float*)x_;
          C.G = g_; bx = b_; C.tid = t_; C.lane = t_ & 63; C.wave = __builtin_amdgcn_readfirstlane(t_ >> 6); C.gw = b_ * NWAVES + C.wave; C.NGW = g_ * NWAVES; }
        unsigned* ctl = (unsigned*)(C.ws + WS_CTL);
        if (q == 0 || q == PH_PER_LAYER - 3) {
            const int second = q != 0;
            if (l == 0 && q == 0) {
                if (bx == 0) { unsigned* cz = (unsigned*)(C.ws + WS_CTL); for (int i = C.tid; i < 16384; i += NTHREADS) cz[i] = 0u; }
                Ctx C2 = C; C2.x = const_cast<float*>(INP(0));
                prep_ffn(C2, INP(2), INP(3), INP(4), INP(1), true);
            } else {
                const size_t wo = (size_t)l * D * FF;
                prep_ffn(C, (second ? INP(23) : INP(2)) + wo, (second ? INP(24) : INP(3)) + wo, (second ? INP(25) : INP(4)) + wo, (second ? INP(22) : INP(1)) + l * D, !(second && C.G == 256));
            }
        } else if (q == 1 || q == PH_PER_LAYER - 2) {
            pg8::Gemm g{(const pg8::bf16_t*)(C.ws + WS_XN), (const pg8::bf16_t*)(C.ws + WS_W1T), M, 2 * FF, D}; pg8::StaticOrder S; S.init(M, 2 * FF, C.G, bx);
            EpiFfnUp E{(bf16*)(C.ws + WS_H)};
            pg8::gemm_phase<EpiFfnUp, pg8::StaticOrder, true, true>(C.lds, g, S, E);
            if (q == 1 && C.G == 256 && bx >= 128) {
                Ctx Ct = C; Ct.gw = (bx - 128) * NWAVES + C.wave; Ct.NGW = 128 * NWAVES;
                mix_transposes(Ct, INP(6) + (size_t)l * D * IN_DIM, INP(20) + (size_t)l * 2816 * D, INP(21) + (size_t)l * D * D, MIXTR_IN, MIXTR_ALL - MIXTR_IN);
            }
        } else if (q == 2 || q == PH_PER_LAYER - 1) {
            pg8::Gemm g{(const pg8::bf16_t*)(C.ws + WS_H), (const pg8::bf16_t*)(C.ws + WS_W2T), M, D, FF}; pg8::StaticOrder S; S.init(M, D, C.G, bx);
            EpiResid E{C.x, 0.5f, (l == 0 && q == 2) ? INP(0) : C.x};
            pg8::gemm_phase<EpiResid, pg8::StaticOrder, true, true>(C.lds, g, S, E);
        } else if (q == 3) {
            prep_mix(C, INP(6) + (size_t)l * D * IN_DIM, INP(20) + (size_t)l * 2816 * D, INP(21) + (size_t)l * D * D, INP(5) + l * D);
        } else if (q == 4 + 6 * NSPLIT) {
            pg8::Gemm g{(const pg8::bf16_t*)(C.ws + WS_XN), (const pg8::bf16_t*)(C.ws + WS_WOUT), M, D, D}; pg8::StaticOrder S; S.init(M, D, C.G, bx);
            EpiResid E{C.x, 1.0f, C.x};
            pg8::gemm_phase<EpiResid, pg8::StaticOrder, true, true>(C.lds, g, S, E);
        } else {
            const int s = (q - 4) / 6, sq = (q - 4) % 6;
            if (sq == 0) {
                pg8::Gemm g{(const pg8::bf16_t*)(C.ws + WS_XN) + (size_t)s * MS * D, (const pg8::bf16_t*)(C.ws + WS_WINT), MS, NPROJ, D}; pg8::StaticOrder S; S.init(MS, NPROJ, C.G, bx);
                EpiInProj E{C.ws};
                pg8::gemm_phase<EpiInProj, pg8::StaticOrder, true, true>(C.lds, g, S, E);
            } else if (sq == 1 || sq == 2) {
                constexpr int NCH = BS * 16;
                if (sq == 2 && bx < NCH) {
#ifndef NO_SEQ
                    dn_seq_chain(C, l, s, bx >> 4, (bx >> 1) & 7, bx & 1);
#endif
                } else {
                    unsigned* ctr = ctl + 64 * (1 + (l * NSPLIT + s) * 2 + (sq - 1) + 16 * rep);
                    const int n_items = sq == 1 ? N_RG + N_DN : (rep ? N_RG : N_RG + N_AT);
                    for (;;) {
                        __syncthreads();
                        if (C.tid == 0) *slot = (int)atomicAdd(ctr, 1u);
                        __syncthreads();
                        int id = *slot;
                        if (id >= n_items) break;
                        if (id < N_RG) {
#ifndef NO_RG
                            if (sq == 1) rg_item<0>(C, l, id >> 5, (id >> 1) & 15, id & 1); else rg_item<1>(C, l, id >> 5, (id >> 1) & 15, id & 1);
#endif
                            continue; }
                        id -= N_RG;
                        if (sq == 1) {
#ifndef NO_DNL
                            dn_local_item(C, l, s, (id >> 3) & 3, id & 7, id >> 5);
#endif
                            continue; }
#ifndef NO_ATT
                        attn_item(C, l, id / 192, (id % 192) >> 4, id & 15);
#endif
                    }
                }
            } else if (sq == 3) {
                if (!rep) attn_fix(C, bx, 0, C.G);
                if (!rep) yc_finalize(C, l, s);
            } else if (sq == 4) {
                const bf16* G = (const bf16*)(C.ws + WS_GATE); bf16* P = (bf16*)(C.ws + WS_DQ);
                if (C.G == 256) {
                    if (bx < 128) {
                        pg8::StaticOrder S; S.init(MS, D, 128, bx);
                        { pg8::Gemm g{(const pg8::bf16_t*)(C.ws + WS_YA), (const pg8::bf16_t*)(C.ws + WS_WBA), MS, D, 1024}; EpiPart E{G, P};
                          pg8::gemm_phase<EpiPart, pg8::StaticOrder, true, true>(C.lds, g, S, E); }
                        { pg8::Gemm g{(const pg8::bf16_t*)(C.ws + WS_YB), (const pg8::bf16_t*)(C.ws + WS_WBB), MS, D, 768}; EpiPart E{G + (size_t)MS * 1024, P + (size_t)MS * 1024};
                          pg8::gemm_phase<EpiPart, pg8::StaticOrder, true, true>(C.lds, g, S, E); }
                    } else {
                        pg8::StaticOrder S; S.init(MS, D, 128, bx - 128);
                        pg8::Gemm g{(const pg8::bf16_t*)(C.ws + WS_YC_OF(s)), (const pg8::bf16_t*)(C.ws + WS_WBC), MS, D, 1024}; EpiPart E{G + (size_t)2 * MS * 1024, P + (size_t)2 * MS * 1024};
                        pg8::gemm_phase<EpiPart, pg8::StaticOrder, true, true>(C.lds, g, S, E);
                        if (s == NSPLIT - 1) {
                            Ctx Ct = C; Ct.gw = (bx - 128) * NWAVES + C.wave; Ct.NGW = 128 * NWAVES;
                            const size_t wo = (size_t)l * D * FF;
                            ffn_transposes(Ct, INP(23) + wo, INP(24) + wo, INP(25) + wo);
                        }
                    }
                } else {
                    pg8::StaticOrder S; S.init(MS, D, C.G, bx);
                    { pg8::Gemm g{(const pg8::bf16_t*)(C.ws + WS_YA), (const pg8::bf16_t*)(C.ws + WS_WBA), MS, D, 1024}; EpiPart E{G, P};
                      pg8::gemm_phase<EpiPart, pg8::StaticOrder, true, true>(C.lds, g, S, E); }
                    { pg8::Gemm g{(const pg8::bf16_t*)(C.ws + WS_YB), (const pg8::bf16_t*)(C.ws + WS_WBB), MS, D, 768}; EpiPart E{G + (size_t)MS * 1024, P + (size_t)MS * 1024};
                      pg8::gemm_phase<EpiPart, pg8::StaticOrder, true, true>(C.lds, g, S, E); }
                    { pg8::Gemm g{(const pg8::bf16_t*)(C.ws + WS_YC_OF(s)), (const pg8::bf16_t*)(C.ws + WS_WBC), MS, D, 1024}; EpiPart E{G + (size_t)2 * MS * 1024, P + (size_t)2 * MS * 1024};
                      pg8::gemm_phase<EpiPart, pg8::StaticOrder, true, true>(C.lds, g, S, E); }
                }
            } else {
                const v4u* P = (const v4u*)(C.ws + WS_DQ); v4u* Y = (v4u*)(C.ws + WS_YC_OF(s)); const size_t n16 = (size_t)MS * D / 8;
                for (size_t i = (size_t)bx * NTHREADS + C.tid; i < n16; i += (size_t)C.G * NTHREADS) {
                    const v4u a = P[i], b = P[i + n16], c = P[i + 2 * n16]; float x[8], y[8], z[8]; unpack8(a, x); unpack8(b, y); unpack8(c, z);
#pragma unroll
                    for (int e = 0; e < 8; ++e) x[e] = (x[e] + y[e]) + z[e];
                    Y[i] = __builtin_bit_cast(v4u, pack8(x));
                }
            }
        }
        }
        if (ph + 1 < args.ph_hi) grid.sync();
#ifdef PROBE_SYNC
        grid.sync(); grid.sync(); grid.sync();
#endif
    }
}

#ifndef MK_PER_PHASE
#define MK_PER_PHASE 0
#endif
extern "C" void kernel_launch(void* const* d_in, const int* in_sizes, int n_in, void* d_out, int out_size, void* d_ws, size_t ws_size, hipStream_t stream) {
    static int grid = 0;
    if (grid == 0) {
        if (n_in != 26 || out_size != M * D || ws_size < WS_END) { fprintf(stderr, "kernel_launch: unexpected shapes (n_in %d out %d ws %zu)\n", n_in, out_size, ws_size); grid = -1; return; }
        int dev = 0, cus = 0, per_cu = 0;
        hipGetDevice(&dev); hipDeviceGetAttribute(&cus, hipDeviceAttributeMultiprocessorCount, dev);
        if (hipFuncSetAttribute((const void*)fwd_kernel, hipFuncAttributeMaxDynamicSharedMemorySize, LDS_BYTES) != hipSuccess) { fprintf(stderr, "kernel_launch: hipFuncSetAttribute failed\n"); grid = -1; return; }
        if (hipOccupancyMaxActiveBlocksPerMultiprocessor(&per_cu, (const void*)fwd_kernel, NTHREADS, LDS_BYTES) != hipSuccess || per_cu < 1) { fprintf(stderr, "kernel_launch: occupancy query says %d\n", per_cu); per_cu = 1; }
        (void)hipGetLastError();
        grid = cus * (per_cu > 1 ? 1 : per_cu);
        fprintf(stderr, "kernel_launch: grid %d (cus %d per_cu %d)\n", grid, cus, per_cu);
    }
    if (grid < 0) return;
    Args a{};
    for (int i = 0; i < 26; ++i) a.in[i] = (const float*)d_in[i];
    a.out = (float*)d_out; a.ws = (unsigned char*)d_ws;
#if MK_PER_PHASE
    for (int ph = 0; ph < N_PHASES; ++ph) {
        a.ph_lo = ph; a.ph_hi = ph + 1; void* kargs[] = {&a};
        hipError_t e = hipLaunchCooperativeKernel((const void*)fwd_kernel, dim3(grid), dim3(NTHREADS), kargs, LDS_BYTES, stream);
        if (e != hipSuccess) { fprintf(stderr, "cooperative launch failed: %s\n", hipGetErrorString(e)); break; }
    }
#else
    a.ph_lo = 0; a.ph_hi = N_PHASES; void* kargs[] = {&a};
    hipError_t e = hipLaunchCooperativeKernel((const void*)fwd_kernel, dim3(grid), dim3(NTHREADS), kargs, LDS_BYTES, stream);
    if (e != hipSuccess) fprintf(stderr, "cooperative launch failed: %s\n", hipGetErrorString(e));
#endif
}
```
